# Optimizing an MI355X kernel written in HIP

```python
import math
import jax, jax.numpy as jnp
from jax import lax
import numpy as np

D_MODEL = 1024
BATCH = 16
SEQ = 2048
DEPTH = 1

N_HEADS = 8
HEAD_DIM = 64
ATTN_WIDTH = N_HEADS * HEAD_DIM
KV_DIM = HEAD_DIM
N_IDX_HEADS = 8
IDX_DIM = 32
TOPK_KEYS_MAX = 256
Q_BLOCK = 128
POOL_WINDOWS = (2, 4, 8, 16)
N_POOL_GROUPS = 4
POOL_GROUP_DIM = 128
POOL_WIDTH = N_POOL_GROUPS * POOL_GROUP_DIM
N_BRANCHES = 2
IN_COLS = ATTN_WIDTH + 2 * KV_DIM + N_IDX_HEADS * IDX_DIM + IDX_DIM + N_IDX_HEADS + POOL_WIDTH + N_BRANCHES * D_MODEL
N_EXPERTS = 32
EXPERT_TOP_K = 4
D_EXPERT = D_MODEL
SWIGLU_ALPHA = 1.702
SWIGLU_LIMIT = 7.0
EXPERT_BLOCK = 128
RMS_EPS = 1e-5
NEG_INF = -1e30

kernel_name = "hybrid_dsa_pool_moe_block"


def rmsnorm(x, g):
    xf = x.astype(jnp.float32)
    y = xf * lax.rsqrt(jnp.mean(xf * xf, axis=-1, keepdims=True) + RMS_EPS)
    return (y * g.astype(jnp.float32)).astype(x.dtype)


def split_columns(proj):
    sizes = (ATTN_WIDTH, KV_DIM, KV_DIM, N_IDX_HEADS * IDX_DIM, IDX_DIM, N_IDX_HEADS,
             POOL_WIDTH, D_MODEL, D_MODEL)
    offs = [int(o) for o in np.cumsum(sizes)[:-1]]
    return jnp.split(proj, offs, axis=-1)


def dsa_attention(q, k, v, iq, ik, iw):
    B, S = q.shape[0], q.shape[1]
    n_keys = min(TOPK_KEYS_MAX, S // 4)
    nqb = S // Q_BLOCK
    f32 = jnp.float32
    key_pos = jnp.arange(S)
    ikf = ik.astype(f32)
    gather_rows = jax.vmap(lambda a, i: a[i])

    def to_blocks(a):
        return jnp.moveaxis(a.reshape((B, nqb, Q_BLOCK) + a.shape[2:]), 1, 0)

    def one_block(args):
        qb, iqb, iwb, q0 = args
        qpos = q0 + jnp.arange(Q_BLOCK)
        causal = key_pos[None, :] <= qpos[:, None]
        rel = jax.nn.relu(jnp.einsum('bqhd,bsd->bqhs', iqb.astype(f32), ikf))
        score = jnp.einsum('bqh,bqhs->bqs', iwb.astype(f32), rel)
        score = jnp.where(causal[None], score, NEG_INF)
        _, sel = lax.top_k(score, n_keys)
        ks = gather_rows(k, sel).astype(f32)
        vs = gather_rows(v, sel).astype(f32)
        valid = sel <= qpos[None, :, None]
        logits = jnp.einsum('bqhd,bqkd->bqhk', qb.astype(f32), ks) * (HEAD_DIM ** -0.5)
        logits = jnp.where(valid[:, :, None, :], logits, NEG_INF)
        p = jax.nn.softmax(logits, axis=-1)
        return jnp.einsum('bqhk,bqkd->bqhd', p, vs).astype(q.dtype)

    out = lax.map(one_block, (to_blocks(q), to_blocks(iq), to_blocks(iw),
                              jnp.arange(nqb) * Q_BLOCK))
    return jnp.moveaxis(out, 0, 1).reshape(B, S, ATTN_WIDTH)


def multiscale_pool(u, w_pool, pool_scale):
    B, S, _ = u.shape
    uf = u.astype(jnp.float32)
    csum = jnp.cumsum(uf, axis=1)
    t = jnp.arange(S)
    means = []
    for gi, win in enumerate(POOL_WINDOWS):
        cg = csum[..., gi * POOL_GROUP_DIM:(gi + 1) * POOL_GROUP_DIM]
        shifted = jnp.pad(cg, ((0, 0), (win, 0), (0, 0)))[:, :S]
        count = jnp.minimum(t + 1, win).astype(jnp.float32)[None, :, None]
        means.append((cg - shifted) / count)
    pooled = jnp.stack(means, axis=2) - uf.reshape(B, S, N_POOL_GROUPS, POOL_GROUP_DIM)
    mixed = jnp.einsum('bsgc,gcd->bsgd', pooled, w_pool.astype(jnp.float32)).reshape(B, S, POOL_WIDTH)
    return (mixed * pool_scale.astype(jnp.float32)).astype(u.dtype)


def expert_ffn(h, w_router, b_router, w_gate_up, b_gate_up, w_down, b_down):
    B, S, D = h.shape
    T = B * S
    f32 = jnp.float32
    xt = h.reshape(T, D)
    logits = xt.astype(f32) @ w_router.astype(f32) + b_router.astype(f32)
    top_val, top_idx = lax.top_k(logits, EXPERT_TOP_K)
    gate = jax.nn.softmax(top_val, axis=-1)
    A = T * EXPERT_TOP_K
    flat_e = top_idx.reshape(A)
    flat_tok = jnp.arange(A, dtype=jnp.int32) // EXPERT_TOP_K
    flat_g = gate.reshape(A)
    order = jnp.argsort(flat_e)
    se = flat_e[order]
    counts = jnp.bincount(flat_e, length=N_EXPERTS)
    blocks_per = (counts + EXPERT_BLOCK - 1) // EXPERT_BLOCK
    block_end = jnp.cumsum(blocks_per)
    block_start = block_end - blocks_per
    row_start = jnp.cumsum(counts) - counts
    rank = jnp.arange(A) - row_start[se]
    dest = block_start[se] * EXPERT_BLOCK + rank
    nb = A // EXPERT_BLOCK + N_EXPERTS
    P = nb * EXPERT_BLOCK
    row_tok = jnp.full((P,), T, jnp.int32).at[dest].set(flat_tok[order])
    row_g = jnp.zeros((P,), f32).at[dest].set(flat_g[order])
    blk_e = jnp.minimum(jnp.searchsorted(block_end, jnp.arange(nb), side='right'), N_EXPERTS - 1)
    xs = jnp.take(xt, row_tok, axis=0, mode='fill', fill_value=0).reshape(nb, EXPERT_BLOCK, D)

    def expert_block(args):
        xb, e = args
        gu = xb.astype(f32) @ w_gate_up[e].astype(f32) + b_gate_up[e].astype(f32)
        g, u = gu[:, 0::2], gu[:, 1::2]
        g = jnp.minimum(g, SWIGLU_LIMIT)
        u = jnp.clip(u, -SWIGLU_LIMIT, SWIGLU_LIMIT)
        act = (u + 1.0) * (g * jax.nn.sigmoid(SWIGLU_ALPHA * g))
        return act @ w_down[e].astype(f32) + b_down[e].astype(f32)

    ys = lax.map(expert_block, (xs, blk_e)).reshape(P, D)
    out = jax.ops.segment_sum(ys * row_g[:, None], row_tok, num_segments=T)
    return out.reshape(B, S, D).astype(h.dtype)


def setup_inputs(seed: int = 0) -> dict:
    key = jax.random.key(seed)
    ks = jax.random.split(key, 17)
    n = jax.random.normal
    f = jnp.float32
    F2 = 2 * D_EXPERT
    return {
        "x": n(ks[0], (BATCH, SEQ, D_MODEL), f),
        "norm_mix": 1.0 + 0.1 * n(ks[1], (DEPTH, D_MODEL), f),
        "w_in": n(ks[2], (DEPTH, D_MODEL, IN_COLS), f) * D_MODEL ** -0.5,
        "w_pool": n(ks[3], (DEPTH, N_POOL_GROUPS, POOL_GROUP_DIM, POOL_GROUP_DIM), f) * POOL_GROUP_DIM ** -0.5,
        "pool_scale": 1.0 + 0.1 * n(ks[4], (DEPTH, POOL_WIDTH), f),
        "w_attn_up": n(ks[5], (DEPTH, ATTN_WIDTH, D_MODEL), f) * ATTN_WIDTH ** -0.5,
        "w_pool_up": n(ks[6], (DEPTH, POOL_WIDTH, D_MODEL), f) * POOL_WIDTH ** -0.5,
        "w_out": n(ks[7], (DEPTH, D_MODEL, D_MODEL), f) * D_MODEL ** -0.5,
        "norm_ffn": 1.0 + 0.1 * n(ks[8], (DEPTH, D_MODEL), f),
        "w_router": n(ks[9], (DEPTH, D_MODEL, N_EXPERTS), f) * D_MODEL ** -0.5,
        "b_router": 0.01 * n(ks[10], (DEPTH, N_EXPERTS), f),
        "w_gate_up": n(ks[11], (DEPTH, N_EXPERTS, D_MODEL, F2), f) * D_MODEL ** -0.5,
        "b_gate_up": 0.02 * n(ks[12], (DEPTH, N_EXPERTS, F2), f),
        "w_down": n(ks[13], (DEPTH, N_EXPERTS, D_EXPERT, D_MODEL), f) * D_EXPERT ** -0.5,
        "b_down": 0.02 * n(ks[14], (DEPTH, N_EXPERTS, D_MODEL), f),
        "norm_final": 1.0 + 0.1 * n(ks[15], (D_MODEL,), f),
    }


def reference(x, norm_mix, w_in, w_pool, pool_scale, w_attn_up, w_pool_up, w_out, norm_ffn,
              w_router, b_router, w_gate_up, b_gate_up, w_down, b_down, norm_final):
    B, S, _ = x.shape
    idx_w_scale = (N_IDX_HEADS ** -0.5) * (IDX_DIM ** -0.5)
    for l in range(DEPTH):
        h = rmsnorm(x, norm_mix[l])
        proj = h @ w_in[l]
        q, k, v, iq, ik, iw, u, ga, gp = split_columns(proj)
        q = q.reshape(B, S, N_HEADS, HEAD_DIM)
        iq = iq.reshape(B, S, N_IDX_HEADS, IDX_DIM)
        iw = iw * idx_w_scale
        y_attn = dsa_attention(q, k, v, iq, ik, iw)
        y_pool = multiscale_pool(u, w_pool[l], pool_scale[l])
        mixed = (jax.nn.sigmoid(ga) * (y_attn @ w_attn_up[l])
                 + jax.nn.sigmoid(gp) * (y_pool @ w_pool_up[l]))
        x = x + mixed @ w_out[l]
        h2 = rmsnorm(x, norm_ffn[l])
        x = x + expert_ffn(h2, w_router[l], b_router[l], w_gate_up[l], b_gate_up[l], w_down[l], b_down[l])
    return rmsnorm(x, norm_final)
```

```cpp
#include <hip/hip_runtime.h>
#include <cstdio>
#include <cstdint>

#define LAS __attribute__((address_space(3)))
typedef unsigned short bf16_t;
typedef short bf16x8 __attribute__((ext_vector_type(8)));
typedef float f32x4 __attribute__((ext_vector_type(4)));
typedef float f32x2 __attribute__((ext_vector_type(2)));
typedef unsigned u32x4 __attribute__((ext_vector_type(4)));
typedef unsigned u32x2 __attribute__((ext_vector_type(2)));
typedef int i32x4 __attribute__((ext_vector_type(4)));
typedef int i32x8 __attribute__((ext_vector_type(8)));
typedef unsigned char fp8_t;

constexpr int D = 1024, NB = 16, S = 2048, T = NB * S;
constexpr int NH = 8, HD = 64, AW = 512, NIH = 8, IDD = 32, NKEYS = 256;
constexpr int PW = 512, INC = 3496, INP = 3584;
constexpr int NE = 32, TOPK = 4, F2 = 2048;
constexpr float EPS = 1e-5f;
constexpr int C_Q = 0, C_K = 512, C_V = 576, C_IQ = 640, C_IK = 896, C_IW = 928, C_U = 936, C_GA = 1448, C_GP = 2472;

constexpr size_t MiB = 1u << 20;
constexpr size_t WS_CTL = 0;
constexpr size_t WS_LIST = 1 * MiB;
constexpr size_t WS_GATE = 5 * MiB;
constexpr size_t WS_HB = 8 * MiB;
constexpr size_t WS_WIN = 72 * MiB;
constexpr size_t WS_WA = 79 * MiB;
constexpr size_t WS_WC = 80 * MiB;
constexpr size_t WS_WO = 81 * MiB;
constexpr size_t WS_WGU = 84 * MiB;
constexpr size_t WS_WD = 212 * MiB;
constexpr size_t WS_Q = 276 * MiB;
constexpr size_t WS_K = 308 * MiB;
constexpr size_t WS_V = 312 * MiB;
constexpr size_t WS_IQ = 316 * MiB;
constexpr size_t WS_IK = 332 * MiB;
constexpr size_t WS_IW = 334 * MiB;
constexpr size_t WS_U = 336 * MiB;
constexpr size_t WS_SGA = 368 * MiB;
constexpr size_t WS_SGP = 432 * MiB;
constexpr size_t WS_YC = 496 * MiB;
constexpr size_t WS_YA = 560 * MiB;
constexpr size_t WS_MX = 624 * MiB;
constexpr size_t WS_ACT = 276 * MiB;
constexpr size_t WS_Y4 = 688 * MiB;
constexpr size_t WS_WRH = 6 * MiB;
constexpr size_t WS_WRL = 6 * MiB + 65536;
constexpr size_t WS_R2 = 7 * MiB;
constexpr size_t WS_LISTR = 952 * MiB;
constexpr size_t WS_LISTG = 956 * MiB;
constexpr size_t WS_MASK = 944 * MiB;
constexpr size_t WS_END = 960 * MiB;

__device__ __forceinline__ float bf2f(unsigned b) { return __uint_as_float(b << 16); }
__device__ __forceinline__ unsigned f2bf(float f) { unsigned u = __float_as_uint(f); return (u + 0x7fffu + ((u >> 16) & 1u)) >> 16; }
__device__ __forceinline__ unsigned pk2(float lo, float hi) { return f2bf(lo) | (f2bf(hi) << 16); }
__device__ __forceinline__ unsigned cvt_pk_bf16(float lo, float hi) { unsigned r; asm volatile("v_cvt_pk_bf16_f32 %0, %1, %2" : "=v"(r) : "v"(lo), "v"(hi)); return r; }
__device__ __forceinline__ unsigned pk4_fp8(float a, float b, float c, float d) { int w = __builtin_amdgcn_cvt_pk_fp8_f32(a, b, 0, false); w = __builtin_amdgcn_cvt_pk_fp8_f32(c, d, w, true); return (unsigned)w; }
__device__ __forceinline__ float wave_sum(float v) {
#pragma unroll
    for (int o = 32; o >= 1; o >>= 1) v += __shfl_xor(v, o);
    return v;
}
__device__ __forceinline__ float wave_max(float v) {
#pragma unroll
    for (int o = 32; o >= 1; o >>= 1) v = fmaxf(v, __shfl_xor(v, o));
    return v;
}
__device__ __forceinline__ float sigmoidf_(float x) { return __builtin_amdgcn_rcpf(1.0f + __builtin_amdgcn_exp2f(-1.4426950408889634f * x)); }

namespace pg {
constexpr int BM = 256, BK = 64, HALF = 128, HTB = HALF * BK * 2, STAGE_BYTES = 8 * HTB, NXCD = 8, WGM = 4;
__host__ __device__ __forceinline__ int lds_byte(int r, int c) { const int st = (r >> 4) * 2 + (c >> 5), rr = r & 15, cc = c & 31, ob = rr * 64 + cc * 2; return st * 1024 + (ob ^ (((ob >> 9) & 1) << 5)); }
__host__ __device__ __forceinline__ void stage_rc(int b, int& R, int& C) { const int st = b / 1024, sb = b % 1024, swz = sb ^ (((sb >> 9) & 1) << 5); R = (st >> 1) * 16 + swz / 64; C = (st & 1) * 32 + (swz % 64) / 2; }
__host__ __device__ __forceinline__ int perm32(int rho) { const int n = rho >> 4, i = rho & 15; return 8 * (i >> 2) + 4 * n + (i & 3); }

struct Unit { const char* a; const char* b; const int* rl; int nrows; int pm, pn, e; int lpos; };

struct StaticOrder {
    int nM, nN, nwg, G, c; const char* A; const char* Bt; size_t ta, tb;
    __device__ void init(int M, int N, int G_, int c_, const void* A_, int lda, const void* Bt_, int ldb) { nM = M / BM; nN = N / BM; nwg = nM * nN; G = G_; c = c_; A = (const char*)A_; Bt = (const char*)Bt_; ta = (size_t)BM * lda * 2; tb = (size_t)BM * ldb * 2; }
    __device__ bool next(int i, Unit& u) const {
        const long L = (long)i * G + c; if (L >= nwg) return false;
        int wgid = (int)L; { const int q = nwg / NXCD, r = nwg % NXCD, xcd = wgid % NXCD, off = wgid / NXCD; wgid = (xcd < r ? xcd * (q + 1) : r * (q + 1) + (xcd - r) * q) + off; }
        const int nig = WGM * nN, gid = wgid / nig, fm = gid * WGM, gsz = (nM - fm) < WGM ? (nM - fm) : WGM;
        u.pm = fm + ((wgid % nig) % gsz); u.pn = (wgid % nig) / gsz; u.e = 0; u.nrows = BM; u.rl = nullptr; u.lpos = 0;
        u.a = A + (size_t)u.pm * ta; u.b = Bt + (size_t)u.pn * tb; return true;
    }
};

template <class Epi, class Sched, bool GATHER, bool F8 = false>
__device__ __forceinline__ void gemm_phase(LAS unsigned char* lds, const int K, const int lda, const int ldb, const Sched& S, const Epi& E) {
    const int tid = threadIdx.x, wid = __builtin_amdgcn_readfirstlane(tid >> 6), lane = tid & 63, wr = wid >> 2, wc = wid & 3, fr = lane & 15, fq = lane >> 4;
    const int nt = K / BK;
    unsigned voffB[2], c0[2], c1[2], n0[2], n1[2];
    int Rs[2], Cs[2];
#pragma unroll
    for (int i = 0; i < 2; ++i) { int R, C; stage_rc(tid * 16 + i * 8192, R, C); Rs[i] = R; Cs[i] = C; const int Rb = Epi::PERM ? ((R & ~31) + perm32(R & 31)) : R;
        voffB[i] = (unsigned)(Rb * ldb + C) * 2u; c0[i] = (unsigned)(R * lda + C) * 2u; c1[i] = (unsigned)((R + HALF) * lda + C) * 2u; n0[i] = c0[i]; n1[i] = c1[i]; }
    const size_t kstep = (size_t)(BK * 2);
    const size_t hstepB = (size_t)HALF * ldb * 2;
    const unsigned ldsw = (unsigned)wid * 1024u;
    const int aoff = lds_byte(wr * 64 + fr, fq * 8), boff = lds_byte(wc * 32 + fr, fq * 8);
#define PG_GOFF(u, o0, o1) do { _Pragma("unroll") for (int _i = 0; _i < 2; ++_i) { const int _r0 = Rs[_i], _r1 = Rs[_i] + HALF; \
        const int _t0 = (u).rl[_r0 < (u).nrows ? _r0 : 0] >> 2, _t1 = (u).rl[_r1 < (u).nrows ? _r1 : 0] >> 2; \
        o0[_i] = (unsigned)(_t0 * lda + Cs[_i]) * 2u; o1[_i] = (unsigned)(_t1 * lda + Cs[_i]) * 2u; } } while (0)
#define PG_SA(b, h) (((b) * 2 + (h)) * HTB)
#define PG_SB(b, h) ((4 + (b) * 2 + (h)) * HTB)
#define PG_STAGE(bufoff, gbase, voff) do { _Pragma("unroll") for (int _i = 0; _i < 2; ++_i) \
        __builtin_amdgcn_global_load_lds((const unsigned*)((const char*)(gbase) + (voff)[_i]), (LAS unsigned*)(lds + (bufoff) + ldsw + _i * 8192), 16, 0, 0); } while (0)
#define PG_LDA(dst, b, h) do { _Pragma("unroll") for (int m = 0; m < 4; ++m) _Pragma("unroll") for (int k = 0; k < 2; ++k) dst[m][k] = *(const LAS bf16x8*)(lds + PG_SA(b, h) + aoff + m * 2048 + k * 1024); } while (0)
#define PG_LDB(dst, b, h) do { _Pragma("unroll") for (int n = 0; n < 2; ++n) _Pragma("unroll") for (int k = 0; k < 2; ++k) dst[n][k] = *(const LAS bf16x8*)(lds + PG_SB(b, h) + boff + n * 2048 + k * 1024); } while (0)
#define PG_CAT(x0, x1) __builtin_shufflevector(__builtin_bit_cast(i32x4, x0), __builtin_bit_cast(i32x4, x1), 0, 1, 2, 3, 4, 5, 6, 7)
#define PG_MMA(ai, bj, At, Bt) do { __builtin_amdgcn_s_setprio(1); \
        if constexpr (F8) { _Pragma("unroll") for (int m = 0; m < 4; ++m) _Pragma("unroll") for (int n = 0; n < 2; ++n) \
            asm volatile("v_mfma_scale_f32_16x16x128_f8f6f4 %0, %1, %2, %0, %3, %4 op_sel_hi:[0,0,0]" : "+v"(acc[ai][bj][m][n]) : "v"(PG_CAT(Bt[n][0], Bt[n][1])), "v"(PG_CAT(At[m][0], At[m][1])), "v"(sclW), "v"(sclA)); } \
        else { _Pragma("unroll") for (int m = 0; m < 4; ++m) _Pragma("unroll") for (int n = 0; n < 2; ++n) _Pragma("unroll") for (int k = 0; k < 2; ++k) \
            acc[ai][bj][m][n] = __builtin_amdgcn_mfma_f32_16x16x32_bf16(Bt[n][k], At[m][k], acc[ai][bj][m][n], 0, 0, 0); } \
        __builtin_amdgcn_s_setprio(0); } while (0)
#define PG_WAIT_V(n) asm volatile("s_waitcnt vmcnt(" #n ")" ::: "memory")
#define PG_WAIT_L(n) asm volatile("s_waitcnt lgkmcnt(" #n ")" ::: "memory")
#define PG_BAR __builtin_amdgcn_s_barrier()
#define PG_SCHED __builtin_amdgcn_sched_barrier(0)
    Unit cur, nxt; int ui = 0;
    if (!S.next(0, cur)) return;
    f32x4 acc[2][2][4][2];
#pragma unroll
    for (int a = 0; a < 2; ++a)
#pragma unroll
        for (int b = 0; b < 2; ++b)
#pragma unroll
            for (int m = 0; m < 4; ++m)
#pragma unroll
                for (int n = 0; n < 2; ++n) acc[a][b][m][n] = (f32x4){0.f, 0.f, 0.f, 0.f};
    bf16x8 At[4][2], B0[2][2], B1[2][2];
    int sclW = 0x79797979, sclA = 0x7f7f7f7f;
    asm volatile("" : "+v"(sclW), "+v"(sclA));
    const char* cA = cur.a; const char* cB = cur.b;
    if (GATHER) PG_GOFF(cur, c0, c1);
    PG_STAGE(PG_SB(0, 0), cB, voffB); PG_STAGE(PG_SA(0, 0), cA, c0); PG_STAGE(PG_SB(0, 1), cB + hstepB, voffB); PG_STAGE(PG_SA(0, 1), cA, c1);
    if (wr == 1) PG_BAR;
    PG_WAIT_V(4); PG_BAR;
    PG_STAGE(PG_SB(1, 0), cB + kstep, voffB); PG_STAGE(PG_SA(1, 0), cA + kstep, c0); PG_STAGE(PG_SB(1, 1), cB + hstepB + kstep, voffB);
    PG_WAIT_V(6); PG_BAR;
    for (;;) {
        const bool has_next = S.next(ui + 1, nxt);
        const char* nA = has_next ? nxt.a : cA; const char* nB = has_next ? nxt.b : cB;
        if (GATHER) { if (has_next) PG_GOFF(nxt, n0, n1); else { n0[0] = c0[0]; n0[1] = c0[1]; n1[0] = c1[0]; n1[1] = c1[1]; } }
        for (int t = 0; t < nt; t += 2) {
            const bool last = (t == nt - 2);
            const char* a1 = cA + (size_t)(t + 1) * kstep;
            const char* a2 = last ? nA : cA + (size_t)(t + 2) * kstep; const char* b2 = last ? nB : cB + (size_t)(t + 2) * kstep;
            const char* a3 = a2 + kstep; const char* b3 = b2 + kstep;
            unsigned s0[2], s1[2];
            s0[0] = last ? n0[0] : c0[0]; s0[1] = last ? n0[1] : c0[1]; s1[0] = last ? n1[0] : c1[0]; s1[1] = last ? n1[1] : c1[1];
            PG_LDB(B0, 0, 0); PG_SCHED; PG_LDA(At, 0, 0); PG_STAGE(PG_SA(1, 1), a1, c1);
            PG_WAIT_L(8); PG_BAR; PG_WAIT_L(0); PG_MMA(0, 0, At, B0); PG_BAR; PG_SCHED;
            PG_LDB(B1, 0, 1); PG_STAGE(PG_SB(0, 0), b2, voffB);
            PG_BAR; PG_WAIT_L(0); PG_MMA(0, 1, At, B1); PG_BAR;
            PG_LDA(At, 0, 1); PG_STAGE(PG_SA(0, 0), a2, s0);
            PG_BAR; PG_WAIT_L(0); PG_MMA(1, 0, At, B0); PG_BAR; PG_SCHED;
            PG_STAGE(PG_SB(0, 1), b2 + hstepB, voffB);
            PG_WAIT_V(6); PG_BAR; PG_MMA(1, 1, At, B1); PG_BAR;
            PG_LDB(B0, 1, 0); PG_SCHED; PG_LDA(At, 1, 0); PG_STAGE(PG_SA(0, 1), a2, s1);
            PG_WAIT_L(8); PG_BAR; PG_WAIT_L(0); PG_MMA(0, 0, At, B0); PG_BAR; PG_SCHED;
            PG_LDB(B1, 1, 1); PG_STAGE(PG_SB(1, 0), b3, voffB);
            PG_BAR; PG_WAIT_L(0); PG_MMA(0, 1, At, B1); PG_BAR;
            PG_LDA(At, 1, 1); PG_STAGE(PG_SA(1, 0), a3, s0);
            PG_BAR; PG_WAIT_L(0); PG_MMA(1, 0, At, B0); PG_BAR; PG_SCHED;
            PG_STAGE(PG_SB(1, 1), b3 + hstepB, voffB);
            PG_WAIT_V(6); PG_BAR; PG_MMA(1, 1, At, B1); PG_BAR;
        }
        if constexpr (F8) asm volatile("s_nop 15\n\ts_nop 15" ::: "memory");
        E(acc, cur, wr, wc, fr, fq);
        if (!has_next) break;
#pragma unroll
        for (int a = 0; a < 2; ++a)
#pragma unroll
            for (int b = 0; b < 2; ++b)
#pragma unroll
                for (int m = 0; m < 4; ++m)
#pragma unroll
                    for (int n = 0; n < 2; ++n) acc[a][b][m][n] = (f32x4){0.f, 0.f, 0.f, 0.f};
        cur = nxt; cA = nA; cB = nB; ++ui;
        if (GATHER) { c0[0] = n0[0]; c0[1] = n0[1]; c1[0] = n1[0]; c1[1] = n1[1]; }
    }
    PG_WAIT_V(0);
    if (wr == 0) PG_BAR;
    PG_BAR;
#undef PG_GOFF
#undef PG_SA
#undef PG_SB
#undef PG_STAGE
#undef PG_LDA
#undef PG_LDB
#undef PG_MMA
#undef PG_CAT
#undef PG_WAIT_V
#undef PG_WAIT_L
#undef PG_BAR
#undef PG_SCHED
}
}

struct Bufs {
    bf16_t *HB, *WIN, *WA, *WC, *WO, *WGU, *WD, *Q, *K, *V, *IQ, *IK, *U, *SGA, *SGP, *YC, *YA, *MX, *ACT, *Y4;
    float *IW, *GATE; int* LIST; int* CNT; bf16_t *WRH, *WRL; float* R2;
    fp8_t *H8, *WGU8, *WD8, *ACT8; float *LISTR, *LISTG;
};
__device__ __forceinline__ u32x4 pack8(const f32x4& v0, const f32x4& v1) { u32x4 w; w.x = cvt_pk_bf16(v0[0], v0[1]); w.y = cvt_pk_bf16(v0[2], v0[3]); w.z = cvt_pk_bf16(v1[0], v1[1]); w.w = cvt_pk_bf16(v1[2], v1[3]); return w; }
__device__ __forceinline__ void unpack8(const u32x4& w, f32x4& v0, f32x4& v1) {
    v0[0] = bf2f(w.x & 0xffffu); v0[1] = bf2f(w.x >> 16); v0[2] = bf2f(w.y & 0xffffu); v0[3] = bf2f(w.y >> 16);
    v1[0] = bf2f(w.z & 0xffffu); v1[1] = bf2f(w.z >> 16); v1[2] = bf2f(w.w & 0xffffu); v1[3] = bf2f(w.w >> 16); }

struct EpiInProj {
    static constexpr bool PERM = true;
    Bufs B;
    __device__ __forceinline__ void operator()(const f32x4 (&acc)[2][2][4][2], const pg::Unit& u, int wr, int wc, int fr, int fq) const {
        asm volatile("" : "+v"(fr), "+v"(fq));
        const int pn = u.pn;
        bf16_t* base; int pitch, coff; bool sig = false;
        if (pn < 2) { base = B.Q; pitch = 512; coff = pn * 256; }
        else if (pn == 3) { base = B.IQ; pitch = 256; coff = 0; }
        else if (pn < 6) { base = B.U; pitch = 512; coff = (pn - 4) * 256; }
        else if (pn < 10) { base = B.SGA; pitch = 1024; coff = (pn - 6) * 256; sig = true; }
        else { base = B.SGP; pitch = 1024; coff = (pn - 10) * 256; sig = true; }
#pragma unroll
        for (int ai = 0; ai < 2; ++ai)
#pragma unroll
            for (int m = 0; m < 4; ++m) {
                const size_t row = (size_t)u.pm * 256 + ai * 128 + wr * 64 + m * 16 + fr;
#pragma unroll
                for (int bj = 0; bj < 2; ++bj) {
                    const int cc = bj * 128 + wc * 32 + fq * 8;
                    f32x4 v0 = acc[ai][bj][m][0], v1 = acc[ai][bj][m][1];
                    if (pn == 2) {
                        if (cc < 64) *(u32x4*)(B.K + row * 64 + cc) = pack8(v0, v1);
                        else if (cc < 128) *(u32x4*)(B.V + row * 64 + (cc - 64)) = pack8(v0, v1);
                        else if (cc < 160) *(u32x4*)(B.IK + row * 32 + (cc - 128)) = pack8(v0, v1);
                        else if (cc == 160) { *(f32x4*)(B.IW + row * 8) = v0 * 0.0625f; *(f32x4*)(B.IW + row * 8 + 4) = v1 * 0.0625f; }
                    } else {
                        if (sig) {
#pragma unroll
                            for (int j = 0; j < 4; ++j) { v0[j] = sigmoidf_(v0[j]); v1[j] = sigmoidf_(v1[j]); }
                        }
                        *(u32x4*)(base + row * pitch + coff + cc) = pack8(v0, v1);
                    }
                }
            }
    }
};
struct EpiAttnUp {
    static constexpr bool PERM = true;
    Bufs B;
    __device__ __forceinline__ void operator()(const f32x4 (&acc)[2][2][4][2], const pg::Unit& u, int wr, int wc, int fr, int fq) const {
        asm volatile("" : "+v"(fr), "+v"(fq));
#pragma unroll
        for (int ai = 0; ai < 2; ++ai)
#pragma unroll
            for (int m = 0; m < 4; ++m) {
                const size_t row = (size_t)u.pm * 256 + ai * 128 + wr * 64 + m * 16 + fr;
#pragma unroll
                for (int bj = 0; bj < 2; ++bj) {
                    const size_t o = row * 1024 + u.pn * 256 + bj * 128 + wc * 32 + fq * 8;
                    f32x4 g0, g1; unpack8(*(const u32x4*)(B.SGA + o), g0, g1);
                    *(u32x4*)(B.YA + o) = pack8(acc[ai][bj][m][0] * g0, acc[ai][bj][m][1] * g1);
                }
            }
    }
};
struct EpiPoolUp {
    static constexpr bool PERM = true;
    Bufs B;
    __device__ __forceinline__ void operator()(const f32x4 (&acc)[2][2][4][2], const pg::Unit& u, int wr, int wc, int fr, int fq) const {
        asm volatile("" : "+v"(fr), "+v"(fq));
#pragma unroll
        for (int ai = 0; ai < 2; ++ai)
#pragma unroll
            for (int m = 0; m < 4; ++m) {
                const size_t row = (size_t)u.pm * 256 + ai * 128 + wr * 64 + m * 16 + fr;
#pragma unroll
                for (int bj = 0; bj < 2; ++bj) {
                    const size_t o = row * 1024 + u.pn * 256 + bj * 128 + wc * 32 + fq * 8;
                    f32x4 g0, g1, y0, y1; unpack8(*(const u32x4*)(B.SGP + o), g0, g1); unpack8(*(const u32x4*)(B.YA + o), y0, y1);
                    *(u32x4*)(B.MX + o) = pack8(y0 + acc[ai][bj][m][0] * g0, y1 + acc[ai][bj][m][1] * g1);
                }
            }
    }
};
struct EpiOut {
    static constexpr bool PERM = false;
    const float* x; float* x2;
    __device__ __forceinline__ void operator()(const f32x4 (&acc)[2][2][4][2], const pg::Unit& u, int wr, int wc, int fr, int fq) const {
        asm volatile("" : "+v"(fr), "+v"(fq));
#pragma unroll
        for (int ai = 0; ai < 2; ++ai)
#pragma unroll
            for (int m = 0; m < 4; ++m) {
                const size_t row = (size_t)u.pm * 256 + ai * 128 + wr * 64 + m * 16 + fr;
#pragma unroll
                for (int bj = 0; bj < 2; ++bj)
#pragma unroll
                    for (int n = 0; n < 2; ++n) {
                        const size_t o = row * 1024 + u.pn * 256 + bj * 128 + wc * 32 + n * 16 + fq * 4;
                        *(f32x4*)(x2 + o) = *(const f32x4*)(x + o) + acc[ai][bj][m][n];
                    }
            }
    }
};
struct EpiGateUp {
    static constexpr bool PERM = true;
    fp8_t* ACT; const float* bias; const float* LR;
    __device__ __forceinline__ void operator()(const f32x4 (&acc)[2][2][4][2], const pg::Unit& u, int wr, int wc, int fr, int fq) const {
        asm volatile("" : "+v"(fr), "+v"(fq));
        const int ac0 = u.pn * 128 + wc * 32 + fq * 8;
        const float* bp = bias + (size_t)u.e * F2 + 2 * ac0;
        f32x4 bq[4];
#pragma unroll
        for (int j = 0; j < 4; ++j) bq[j] = *(const f32x4*)(bp + 4 * j);
        float rs8[8];
#pragma unroll
        for (int i = 0; i < 8; ++i) { const int rt = (i >> 2) * 128 + wr * 64 + (i & 3) * 16 + fr; rs8[i] = LR[u.lpos + (rt < u.nrows ? rt : 0)]; }
        asm volatile("s_waitcnt vmcnt(0)" ::: "memory");
#pragma unroll
        for (int i = 0; i < 8; ++i) asm volatile("" : "+v"(rs8[i]));
#pragma unroll
        for (int j = 0; j < 4; ++j) asm volatile("" : "+v"(bq[j]));
#pragma unroll
        for (int ai = 0; ai < 2; ++ai)
#pragma unroll
            for (int m = 0; m < 4; ++m) {
                const int rt = ai * 128 + wr * 64 + m * 16 + fr;
                if (rt < u.nrows) {
                    const float rs = rs8[ai * 4 + m];
                    f32x4 o[2];
#pragma unroll
                    for (int n = 0; n < 2; ++n)
#pragma unroll
                        for (int jp = 0; jp < 2; ++jp) {
                            const int c = 4 * n + 2 * jp;
                            const f32x2 ag = {acc[ai][0][m][n][2 * jp], acc[ai][0][m][n][2 * jp + 1]}, au = {acc[ai][1][m][n][2 * jp], acc[ai][1][m][n][2 * jp + 1]};
                            const f32x2 bg = {bq[c >> 1][(c & 1) * 2], bq[(c + 1) >> 1][((c + 1) & 1) * 2]}, bu = {bq[c >> 1][(c & 1) * 2 + 1], bq[(c + 1) >> 1][((c + 1) & 1) * 2 + 1]};
                            f32x2 g = ag * rs + bg, uu = au * rs + bu;
                            g.x = fminf(g.x, 7.0f); g.y = fminf(g.y, 7.0f);
                            uu.x = __builtin_amdgcn_fmed3f(uu.x, -7.0f, 7.0f); uu.y = __builtin_amdgcn_fmed3f(uu.y, -7.0f, 7.0f);
                            const f32x2 t = g * (-1.702f * 1.4426950408889634f);
                            f32x2 e; e.x = __builtin_amdgcn_exp2f(t.x); e.y = __builtin_amdgcn_exp2f(t.y);
                            const f32x2 d = e + 1.0f;
                            f32x2 sg; sg.x = __builtin_amdgcn_rcpf(d.x); sg.y = __builtin_amdgcn_rcpf(d.y);
                            const f32x2 gs = g * sg, r2 = uu * gs + gs;
                            o[n][2 * jp] = r2.x; o[n][2 * jp + 1] = r2.y;
                        }
                    *(u32x2*)(ACT + ((size_t)u.pm * 256 + rt) * 1024 + ac0) = (u32x2){pk4_fp8(o[0][0], o[0][1], o[0][2], o[0][3]), pk4_fp8(o[1][0], o[1][1], o[1][2], o[1][3])};
                }
            }
    }
};
struct EpiDown {
    static constexpr bool PERM = true;
    fp8_t* Y4; const float* bias; const float* gates; const int* LI;
    __device__ __forceinline__ void operator()(const f32x4 (&acc)[2][2][4][2], const pg::Unit& u, int wr, int wc, int fr, int fq) const {
        asm volatile("" : "+v"(fr), "+v"(fq));
        f32x4 bq[2][2];
#pragma unroll
        for (int bj = 0; bj < 2; ++bj) { const float* bp = bias + (size_t)u.e * 1024 + u.pn * 256 + bj * 128 + wc * 32 + fq * 8; bq[bj][0] = *(const f32x4*)bp; bq[bj][1] = *(const f32x4*)(bp + 4); }
        int a8[8]; float g8[8];
#pragma unroll
        for (int i = 0; i < 8; ++i) { const int rt = (i >> 2) * 128 + wr * 64 + (i & 3) * 16 + fr; const int q = u.lpos + (rt < u.nrows ? rt : 0); a8[i] = LI[q]; g8[i] = gates[q]; }
        asm volatile("s_waitcnt vmcnt(0)" ::: "memory");
#pragma unroll
        for (int i = 0; i < 8; ++i) asm volatile("" : "+v"(a8[i]), "+v"(g8[i]));
#pragma unroll
        for (int bj = 0; bj < 2; ++bj) asm volatile("" : "+v"(bq[bj][0]), "+v"(bq[bj][1]));
#pragma unroll
        for (int ai = 0; ai < 2; ++ai)
#pragma unroll
            for (int m = 0; m < 4; ++m) {
                const int rt = ai * 128 + wr * 64 + m * 16 + fr;
                if (rt < u.nrows) {
                    const int a = a8[ai * 4 + m]; const float gt = g8[ai * 4 + m] * 8.0f;
#pragma unroll
                    for (int bj = 0; bj < 2; ++bj) {
                        const f32x4 y0 = (acc[ai][bj][m][0] + bq[bj][0]) * gt, y1 = (acc[ai][bj][m][1] + bq[bj][1]) * gt;
                        *(u32x2*)(Y4 + (size_t)a * 1024 + u.pn * 256 + bj * 128 + wc * 32 + fq * 8) = (u32x2){pk4_fp8(y0[0], y0[1], y0[2], y0[3]), pk4_fp8(y1[0], y1[1], y1[2], y1[3])};
                    }
                }
            }
    }
};

struct MoeOrder {
    const LAS int* tab; int NT, G, c, total; const char* Abase; const char* Bbase; size_t bexp; const int* list; bool dense_a;
    __device__ bool next(int i, pg::Unit& u) const {
        const long L = (long)i * G + c; if (L >= total) return false;
        int e = 0;
        for (int j = 1; j < NE; ++j) e += (tab[j] <= (int)L) ? 1 : 0;
        e = __builtin_amdgcn_readfirstlane(e);
        const int l = (int)L - __builtin_amdgcn_readfirstlane(tab[e]), rt = l / NT, pn = l - rt * NT;
        const int cnt = __builtin_amdgcn_readfirstlane(tab[64 + e]), ro = __builtin_amdgcn_readfirstlane(tab[128 + e]);
        u.e = e; u.pn = pn; u.pm = ro + rt; u.nrows = (cnt - rt * 256) < 256 ? (cnt - rt * 256) : 256;
        u.rl = list + (size_t)e * T + rt * 256; u.lpos = e * T + rt * 256;
        u.a = dense_a ? Abase + (size_t)(ro + rt) * 256 * 1024 : Abase;
        u.b = Bbase + (size_t)e * bexp + (size_t)pn * 256 * 1024;
        return true;
    }
};

__device__ __forceinline__ int inproj_src(int n) {
    if (n < 512) return C_Q + n;
    if (n < 576) return C_K + (n - 512);
    if (n < 640) return C_V + (n - 576);
    if (n < 672) return C_IK + (n - 640);
    if (n < 680) return C_IW + (n - 672);
    if (n < 768) return -1;
    if (n < 1024) return C_IQ + (n - 768);
    if (n < 1536) return C_U + (n - 1024);
    if (n < 2560) return C_GA + (n - 1536);
    return C_GP + (n - 2560);
}
template <int MODE> __device__ __forceinline__ void transpose_item(const float* W, int K, int N, bf16_t* WT, LAS float* scr, int item, int nblk, int lane) {
    const int kb = item / nblk, nb = item % nblk, k0 = 64 * kb, n0 = 32 * nb;
    const int nd = n0 + (lane & 31);
    int sc;
    if (MODE == 0) sc = nd; else if (MODE == 1) sc = inproj_src(nd); else { const int p = nd >> 8, bj = (nd >> 7) & 1, i = nd & 127; sc = 2 * (128 * p + i) + bj; }
#pragma unroll 8
    for (int i = 0; i < 32; ++i) { const int kk = 2 * i + (lane >> 5); scr[kk * 33 + (lane & 31)] = (sc >= 0) ? W[(size_t)(k0 + kk) * N + sc] : 0.f; }
    asm volatile("s_waitcnt lgkmcnt(0)" ::: "memory");
    const int c = lane & 7;
#pragma unroll
    for (int j = 0; j < 4; ++j) { const int n = (lane >> 3) + 8 * j; const LAS float* s = scr + (8 * c) * 33 + n;
        u32x4 o; o.x = pk2(s[0 * 33], s[1 * 33]); o.y = pk2(s[2 * 33], s[3 * 33]); o.z = pk2(s[4 * 33], s[5 * 33]); o.w = pk2(s[6 * 33], s[7 * 33]);
        *(u32x4*)(WT + (size_t)(n0 + n) * K + k0 + 8 * c) = o; }
    asm volatile("s_waitcnt lgkmcnt(0)" ::: "memory");
}

template <int MODE> __device__ __forceinline__ void transpose_item_f8(const float* W, int K, int N, fp8_t* WT, LAS float* scr, int item, int nblk, int lane) {
    const int kb = item / nblk, nb = item % nblk, k0 = 64 * kb, n0 = 32 * nb;
    const int nd = n0 + (lane & 31);
    int sc;
    if (MODE == 0) sc = nd; else { const int p = nd >> 8, bj = (nd >> 7) & 1, i = nd & 127; sc = 2 * (128 * p + i) + bj; }
    float v[32];
#pragma unroll
    for (int i = 0; i < 32; ++i) v[i] = W[(size_t)(k0 + 2 * i + (lane >> 5)) * N + sc];
#pragma unroll
    for (int i = 0; i < 32; ++i) scr[(2 * i + (lane >> 5)) * 33 + (lane & 31)] = v[i] * 64.0f;
    asm volatile("s_waitcnt lgkmcnt(0)" ::: "memory");
    const int c = lane & 3;
#pragma unroll
    for (int j = 0; j < 2; ++j) { const int n = (lane >> 2) + 16 * j; const LAS float* s = scr + (16 * c) * 33 + n;
        u32x4 o; o.x = pk4_fp8(s[0 * 33], s[1 * 33], s[2 * 33], s[3 * 33]); o.y = pk4_fp8(s[4 * 33], s[5 * 33], s[6 * 33], s[7 * 33]);
        o.z = pk4_fp8(s[8 * 33], s[9 * 33], s[10 * 33], s[11 * 33]); o.w = pk4_fp8(s[12 * 33], s[13 * 33], s[14 * 33], s[15 * 33]);
        *(u32x4*)(WT + (size_t)(n0 + n) * K + k0 + 16 * c) = o; }
    asm volatile("s_waitcnt lgkmcnt(0)" ::: "memory");
}

struct Args {
    const float* in[16]; float* out; unsigned char* ws; int ph_lo, ph_hi;
};

constexpr int LDS_XB = 151552 - 64;
constexpr int CW_BAR = 1024;
constexpr int LDS_TAB = pg::STAGE_BYTES;
constexpr int LDS_BYTES = 151552;

__device__ __forceinline__ void moe_tables(LAS int* tab, const int* cnt_g, int NT) {
    if (threadIdx.x < 64) {
        const int lane = threadIdx.x;
        const int c = lane < NE ? __hip_atomic_load(cnt_g + lane, __ATOMIC_RELAXED, __HIP_MEMORY_SCOPE_AGENT) : 0;
        const int rt = (c + 255) >> 8;
        int pre = rt;
#pragma unroll
        for (int o = 1; o < 64; o <<= 1) { const int v = __shfl_up(pre, o); if (lane >= o) pre += v; }
        const int excl = pre - rt;
        if (lane < NE) { tab[lane] = excl * NT; tab[64 + lane] = c; tab[128 + lane] = excl; }
        if (lane == NE) { tab[NE] = excl * NT; tab[128 + NE] = excl; }
    }
    __syncthreads();
}


typedef float f32x16 __attribute__((ext_vector_type(16)));
__device__ __forceinline__ int wave_total_le32(int c) {
    int tot = 0;
#pragma unroll
    for (int b = 0; b < 6; ++b) tot += __builtin_popcountll(__ballot((c >> b) & 1)) << b;
    return tot;
}
__device__ __forceinline__ unsigned ord_key(float f) { const unsigned u = __float_as_uint(f); return u ^ ((unsigned)((int)u >> 31) | 0x80000000u); }
template <int CTRL> __device__ __forceinline__ float dppf(float v) { return __int_as_float(__builtin_amdgcn_update_dpp(0, __float_as_int(v), CTRL, 0xf, 0xf, true)); }
__device__ __forceinline__ float wave_max_u(float v) {
    v = fmaxf(v, dppf<0xB1>(v)); v = fmaxf(v, dppf<0x4E>(v)); v = fmaxf(v, dppf<0x141>(v)); v = fmaxf(v, dppf<0x140>(v));
    const int b = __float_as_int(v);
    return fmaxf(fmaxf(__int_as_float(__builtin_amdgcn_readlane(b, 0)), __int_as_float(__builtin_amdgcn_readlane(b, 16))), fmaxf(__int_as_float(__builtin_amdgcn_readlane(b, 32)), __int_as_float(__builtin_amdgcn_readlane(b, 48))));
}
__device__ __forceinline__ int wave_incl_scan(int v) {
    v += __builtin_amdgcn_update_dpp(0, v, 0x111, 0xf, 0xf, false);
    v += __builtin_amdgcn_update_dpp(0, v, 0x112, 0xf, 0xf, false);
    v += __builtin_amdgcn_update_dpp(0, v, 0x114, 0xf, 0xf, false);
    v += __builtin_amdgcn_update_dpp(0, v, 0x118, 0xf, 0xf, false);
    v += __builtin_amdgcn_update_dpp(0, v, 0x142, 0xa, 0xf, false);
    v += __builtin_amdgcn_update_dpp(0, v, 0x143, 0xc, 0xf, false);
    return v;
}
__device__ __forceinline__ unsigned select_word(const float (&x)[32], unsigned vm, int lane, LAS int* hist, LAS float* cval, const LAS float* srow) {
    unsigned active = vm, sel = 0u; int need = NKEYS;
    for (;;) {
        float mnn = -__builtin_inff(), mxx = -__builtin_inff();
#pragma unroll
        for (int i = 0; i < 32; ++i) { const bool a = (active >> i) & 1u; mnn = a ? fmaxf(mnn, -x[i]) : mnn; mxx = a ? fmaxf(mxx, x[i]) : mxx; }
        const float mn = -wave_max_u(mnn), mx = wave_max_u(mxx);
        const float scale = 256.0f / (mx - mn);
        if (!(scale < 1.0e37f)) {
            if (mn == mx) {
                const int c = __builtin_popcount(active); const int incl = wave_incl_scan(c);
                int allow = need - (incl - c);
#pragma unroll
                for (int i = 0; i < 32; ++i) { const bool a = (active >> i) & 1u; if (a && allow > 0) sel |= 1u << i; if (a) --allow; }
                return sel;
            }
            const unsigned kmax = ord_key(mx); const unsigned span = kmax - ord_key(mn); const int nbits = 32 - __builtin_clz(span); const int shift = nbits > 6 ? nbits - 6 : 0;
            *(LAS f32x4*)(hist + 4 * lane) = (f32x4){0.f, 0.f, 0.f, 0.f};
#pragma unroll
            for (int i = 0; i < 32; ++i) { const int b = (int)((kmax - ord_key(x[i])) >> shift); __hip_atomic_fetch_add(&hist[((active >> i) & 1u) ? b : 255], (int)((active >> i) & 1u), __ATOMIC_RELAXED, __HIP_MEMORY_SCOPE_WAVEFRONT); }
            const int h = hist[lane];
            const int incl = wave_incl_scan(h);
            const int Ls = __builtin_ctzll(__ballot(incl >= need));
            const int above = __builtin_amdgcn_readlane(incl, Ls) - __builtin_amdgcn_readlane(h, Ls), cnt = __builtin_amdgcn_readlane(h, Ls);
            unsigned na = 0u;
#pragma unroll
            for (int i = 0; i < 32; ++i) { const int b = (int)((kmax - ord_key(x[i])) >> shift); const unsigned bit = active & (1u << i); sel |= (b < Ls) ? bit : 0u; na |= (b == Ls) ? bit : 0u; }
            active = na; need -= above;
            if (cnt <= 64) break;
            continue;
        }
        *(LAS f32x4*)(hist + 4 * lane) = (f32x4){0.f, 0.f, 0.f, 0.f};
#pragma unroll
        for (int i = 0; i < 32; ++i) {
            int b = (int)((mx - x[i]) * scale); b = b < 0 ? 0 : (b > 255 ? 255 : b);
            __hip_atomic_fetch_add(&hist[b], (int)((active >> i) & 1u), __ATOMIC_RELAXED, __HIP_MEMORY_SCOPE_WAVEFRONT);
        }
        const int h0 = hist[4 * lane], h1 = hist[4 * lane + 1], h2 = hist[4 * lane + 2], h3 = hist[4 * lane + 3];
        const int L = h0 + h1 + h2 + h3, incl = wave_incl_scan(L);
        const int Ls = __builtin_ctzll(__ballot(incl >= need));
        int c = __builtin_amdgcn_readlane(incl, Ls) - __builtin_amdgcn_readlane(L, Ls);
        const int g0 = __builtin_amdgcn_readlane(h0, Ls), g1 = __builtin_amdgcn_readlane(h1, Ls), g2 = __builtin_amdgcn_readlane(h2, Ls), g3 = __builtin_amdgcn_readlane(h3, Ls);
        int Bs = 4 * Ls, cnt = g0;
        if (c + g0 < need) { c += g0; Bs += 1; cnt = g1; if (c + g1 < need) { c += g1; Bs += 1; cnt = g2; if (c + g2 < need) { c += g2; Bs += 1; cnt = g3; } } }
        const float fB = (float)Bs, fB1 = (float)(Bs + 1);
        unsigned na = 0u;
#pragma unroll
        for (int i = 0; i < 32; ++i) {
            const float q = (mx - x[i]) * scale; const unsigned bit = active & (1u << i);
            const bool lt = q < fB, inb = (q >= fB) && (q < fB1 || Bs == 255);
            sel |= lt ? bit : 0u; na |= inb ? bit : 0u;
        }
        active = na; need -= c;
        if (cnt <= 64) break;
    }
    LAS f32x2* cv2 = (LAS f32x2*)cval;
    const int cmine = __builtin_popcount(active);
    int pos = wave_incl_scan(cmine) - cmine;
    const int base = __builtin_amdgcn_readlane(pos, 63) + __builtin_amdgcn_readlane(cmine, 63);
    {
        unsigned rem = active;
        while (__ballot(rem != 0u) != 0ull) {
            if (rem != 0u) { const int i = __builtin_ctz(rem); rem &= rem - 1u; cv2[pos++] = (f32x2){srow[32 * lane + i], __int_as_float(32 * lane + i)}; }
        }
    }
    const int m = base, me = lane < m ? lane : 0;
    const f32x2 mine = cv2[me]; const float v = mine.x; const int id = __float_as_int(mine.y);
    int rank = 0;
    for (int u = 0; u < m; ++u) { const f32x2 o = cv2[u]; const int iu = __float_as_int(o.y); rank += (o.x > v || (o.x == v && iu < id)) ? 1 : 0; }
    const unsigned long long hit = __ballot(lane < m && rank == need - 1);
    const int src = __builtin_ctzll(hit);
    const float P = __int_as_float(__builtin_amdgcn_readlane(__float_as_int(v), src)); const int Pidx = __builtin_amdgcn_readlane(id, src);
#pragma unroll
    for (int i = 0; i < 32; ++i) { const unsigned bit = active & (1u << i); sel |= (x[i] > P || (x[i] == P && 32 * lane + i <= Pidx)) ? bit : 0u; }
    return sel;
}
__device__ __forceinline__ void dsa_mask_phase(LAS unsigned char* lds, const Bufs& B, unsigned* MASK, int G, int vcu) {
    LAS float* sc = (LAS float*)lds;
    const int tid = threadIdx.x, lane = tid & 63, wid = __builtin_amdgcn_readfirstlane(tid >> 6), r32 = lane & 31, hi = lane >> 5;
    const int npairs = NB * 64;
    for (int pr = vcu; pr < npairs; pr += G) {
        for (int s2 = 0; s2 < 2; ++s2) {
            const int b = pr >> 6, kk = pr & 63, ti = s2 ? 127 - kk : kk;
            const int t0 = ti * 16, row0 = b * S + t0, nkb = (t0 + 16 + 31) >> 5;
            bf16x8 af[4][2];
            {
                const int a = r32 >> 4, bb = (r32 >> 3) & 1, c = (r32 >> 2) & 1, d = r32 & 3;
                const int tokl = 2 * c + a, head = 4 * bb + d;
#pragma unroll
                for (int rb = 0; rb < 4; ++rb)
#pragma unroll
                    for (int ks = 0; ks < 2; ++ks) af[rb][ks] = *(const bf16x8*)(B.IQ + (size_t)(row0 + 4 * rb + tokl) * 256 + head * 32 + 16 * ks + 8 * hi);
            }
            LAS float* wl = (LAS float*)(lds + 147456);
            __syncthreads();
            if (tid < 128) wl[tid] = B.IW[(size_t)row0 * 8 + tid];
            __syncthreads();
            for (int kb = wid; kb < nkb; kb += 8) {
                const int key = 32 * kb + r32;
                const bf16x8 bf0 = *(const bf16x8*)(B.IK + (size_t)(b * S + key) * 32 + 8 * hi);
                const bf16x8 bf1 = *(const bf16x8*)(B.IK + (size_t)(b * S + key) * 32 + 16 + 8 * hi);
#pragma unroll
                for (int rb = 0; rb < 4; ++rb) {
                    f32x16 acc = {};
                    acc = __builtin_amdgcn_mfma_f32_32x32x16_bf16(af[rb][0], bf0, acc, 0, 0, 0);
                    acc = __builtin_amdgcn_mfma_f32_32x32x16_bf16(af[rb][1], bf1, acc, 0, 0, 0);
#pragma unroll
                    for (int a = 0; a < 2; ++a) {
                        float sv = 0.f;
#pragma unroll
                        for (int bb = 0; bb < 2; ++bb)
                        { const f32x4 wv = *(const LAS f32x4*)(wl + (4 * rb + 2 * hi + a) * 8 + 4 * bb);
#pragma unroll
                            for (int d = 0; d < 4; ++d) sv = fmaf(wv[d], fmaxf(acc[8 * a + 4 * bb + d], 0.f), sv); }
                        sc[(4 * rb + 2 * hi + a) * 2048 + key] = sv;
                    }
                }
            }
            __syncthreads();
#pragma unroll 1
            for (int qq = 0; qq < 2; ++qq) {
                const int ql = 2 * wid + qq, t = t0 + ql, nk = t + 1;
                unsigned word;
                const int kbase = 32 * lane;
                const int nb = t - kbase + 1;
                const unsigned vm = nb >= 32 ? 0xffffffffu : (nb <= 0 ? 0u : ((1u << nb) - 1u));
                if (nk <= NKEYS) word = vm;
                else {
                    float xv[32];
#pragma unroll
                    for (int j = 0; j < 8; ++j) {
                        const f32x4 v = *(const LAS f32x4*)(sc + ql * 2048 + kbase + 4 * j);
                        xv[4 * j] = v[0]; xv[4 * j + 1] = v[1]; xv[4 * j + 2] = v[2]; xv[4 * j + 3] = v[3];
                    }
                    word = select_word(xv, vm, lane, (LAS int*)(lds + 131072 + wid * 2048), (LAS float*)(lds + 131072 + wid * 2048 + 1024), sc + ql * 2048);
                }
                MASK[(size_t)(row0 + ql) * 64 + lane] = word;
            }
        }
    }
    __syncthreads();
}

namespace att {
typedef short s16x4 __attribute__((ext_vector_type(4)));
typedef short v4i16_t __attribute__((ext_vector_type(4)));
constexpr int NW = 8, QBLK = 32, QB = QBLK * NW, KVBLK = 64, NQB = S / QB, DMQ = 512, DMK = 64, DMO = 1024;
constexpr float C2 = 0.125f * 1.4426950408889634f;
constexpr float NEGM = -1.0e30f, MFLOOR = -1.0e5f;
constexpr int THR = 8;
constexpr int SLOTB = 8192, LDS_K = 0, LDS_V = 3 * SLOTB, LDS_WS = 6 * SLOTB, LDS_OST = LDS_WS + NW * 256, LDS_MK = LDS_OST + NW * 4096, LDS_END = LDS_MK + 32 * 2048;
#define SBAR() __builtin_amdgcn_sched_barrier(0)
#define PIN(x) asm volatile("" : "+v"(x))
#define MFMA32(a, b, c) __builtin_amdgcn_mfma_f32_32x32x16_bf16(a, b, c, 0, 0, 0)
#define WAIT_BAR(N) asm volatile("s_waitcnt vmcnt(" #N ") lgkmcnt(0)\n\ts_barrier" ::: "memory")
__device__ __forceinline__ int crow(int r, int hi) { return (r & 3) + 8 * (r >> 2) + 4 * hi; }
__device__ __forceinline__ unsigned cvtpk(float lo, float hi) { unsigned r; asm("v_cvt_pk_bf16_f32 %0, %1, %2" : "=v"(r) : "v"(lo), "v"(hi)); return r; }
__device__ __forceinline__ void glds16(const void* g, unsigned lds_base) {
    unsigned sv; asm volatile("s_mov_b32 %0, m0\n\ts_mov_b32 m0, %2\n\ts_nop 0\n\tglobal_load_lds_dwordx4 %1, off\n\ts_mov_b32 m0, %0" : "=&s"(sv) : "v"(g), "s"(lds_base) : "memory"); }
typedef LAS const char* lds_cptr;
__device__ __forceinline__ void kload2(bf16x8* kf, lds_cptr kp, int d0) { kf[2 * d0] = *(const LAS bf16x8*)(kp + d0 * 2048); kf[2 * d0 + 1] = *(const LAS bf16x8*)(kp + d0 * 2048 + 512); }
__device__ __forceinline__ s16x4 vtr(lds_cptr p) { return __builtin_bit_cast(s16x4, __builtin_amdgcn_ds_read_tr16_b64_v4i16((LAS v4i16_t*)p)); }
#define MX3(a, b, c) __builtin_fmaxf(__builtin_fmaxf((a), (b)), (c))
__device__ __forceinline__ float rowmax(const f32x16& p0, const f32x16& p1) {
    float a = MX3(p0[0], p0[1], p1[0]), b = MX3(p0[2], p0[3], p1[1]); a = MX3(a, p1[2], p1[3]);
#pragma unroll
    for (int r = 4; r < 16; r += 4) { a = MX3(a, p0[r], p0[r + 1]); b = MX3(b, p0[r + 2], p0[r + 3]); a = MX3(a, p1[r], p1[r + 1]); b = MX3(b, p1[r + 2], p1[r + 3]); }
    float m = __builtin_fmaxf(a, b); auto rr = __builtin_amdgcn_permlane32_swap(__float_as_uint(m), __float_as_uint(m), false, false);
    return __builtin_fmaxf(__uint_as_float(rr[0]), __uint_as_float(rr[1])); }
__device__ __forceinline__ void amask(f32x16& p0, f32x16& p1, unsigned w0, unsigned w1, int hi) {
    const unsigned a = w0 >> (4 * hi), b = w1 >> (4 * hi);
#pragma unroll
    for (int r = 0; r < 16; ++r) { const int bit = (r & 3) + 8 * (r >> 2); if (!((a >> bit) & 1u)) p0[r] = NEGM; if (!((b >> bit) & 1u)) p1[r] = NEGM; } }

__device__ __forceinline__ void attn_unit(int b, int h, int qb, const bf16_t* Q, const bf16_t* __restrict__ K, const bf16_t* __restrict__ V, const unsigned* __restrict__ MASK, bf16_t* O, LAS char* lds) {
    const int tid = threadIdx.x, lane = tid & 63, r32 = lane & 31, hi = lane >> 5; const int wid = __builtin_amdgcn_readfirstlane(tid >> 6);
    const long rowbase = (long)b * S; const int q0 = qb * QB, NT = (q0 + QB) / KVBLK;
    const bf16_t* Qw = Q + (rowbase + q0 + wid * QBLK) * DMQ + h * 64;
    const unsigned lds0 = (unsigned)(uintptr_t)lds; LAS float* wsf = (LAS float*)(lds + LDS_WS) + wid * 64;
    {
        const unsigned* mrow = MASK + (size_t)(rowbase + q0 + (tid >> 1)) * 64 + (tid & 1) * 32;
        u32x4 mv[8];
#pragma unroll
        for (int j = 0; j < 8; ++j) mv[j] = *(const u32x4*)(mrow + 4 * j);
#pragma unroll
        for (int j = 0; j < 8; ++j) {
            const int tl = (tid & 1) * 16 + 2 * j;
            *(LAS u32x2*)(lds + LDS_MK + tl * 2048 + (tid >> 1) * 8) = (u32x2){mv[j].x, mv[j].y};
            *(LAS u32x2*)(lds + LDS_MK + (tl + 1) * 2048 + (tid >> 1) * 8) = (u32x2){mv[j].z, mv[j].w};
        }
    }
    const LAS char* mkp = lds + LDS_MK + (wid * QBLK + r32) * 8;
    const bf16_t* ksrc = K + rowbase * DMK + (long)lane * DMK + wid * 8;
    const bf16_t* vsrc = V + rowbase * DMK + (long)(16 * (wid & 3) + (lane >> 2)) * DMK + (wid >> 2) * 32 + (lane & 3) * 8;
    const unsigned kdst = lds0 + LDS_K + wid * 1024, vdst = lds0 + LDS_V + wid * 1024;
#define DMA_K(t, slot) glds16(ksrc + (long)(t) * KVBLK * DMK, (unsigned)__builtin_amdgcn_readfirstlane(kdst + (slot)))
#define DMA_V(t, slot) glds16(vsrc + (long)(t) * KVBLK * DMK, (unsigned)__builtin_amdgcn_readfirstlane(vdst + (slot)))
    const lds_cptr vp0 = (lds_cptr)lds + LDS_V + ((lane >> 4) & 1) * 32 + (lane & 3) * 8 + (4 * hi + ((lane & 15) >> 2)) * 64;
    const lds_cptr kp0 = (lds_cptr)lds + LDS_K + hi * 1024 + r32 * 16;
    asm volatile("s_waitcnt vmcnt(0)" ::: "memory");
    DMA_K(0, 0); DMA_V(0, 0); DMA_K(1, SLOTB);
    bf16x8 qr[4];
#pragma unroll
    for (int d0 = 0; d0 < 4; ++d0) qr[d0] = *reinterpret_cast<const bf16x8*>(&Qw[(long)r32 * DMQ + d0 * 16 + hi * 8]);
    float mhat = 0.f, l_reg = 0.f; f32x16 o[2]; o[0] = f32x16{}; o[1] = f32x16{};
    const f32x16 zero16 = f32x16{};
    bool resc = false;
    f32x16 pA0, pA1, pB0, pB1; bf16x8 kf[8]; s16x4 vlo[8], vhi[8]; u32x4 pw0, pw1, pw2, pw3;
    int sl_prev = 0, sl_cur = 0, sl_next = SLOTB;
#define ROT() do { sl_prev = sl_cur; sl_cur = sl_next; sl_next = (sl_next == 2 * SLOTB) ? 0 : sl_next + SLOTB; } while (0)
#define EX(v) __builtin_amdgcn_exp2f(__builtin_fmaf((v), C2, nmh))
#define RESC() do { if (resc) { _Pragma("unroll") for (int d_ = 0; d_ < 2; ++d_) _Pragma("unroll") for (int r = 0; r < 16; ++r) o[d_][r] *= wsf[crow(r, hi)]; } } while (0)
    DMA_K(2, 2 * SLOTB);
    WAIT_BAR(3);
    _Pragma("unroll") for (int d0 = 0; d0 < 4; ++d0) kload2(kf, kp0, d0);
    pA0 = MFMA32(kf[0], qr[0], zero16); pA1 = MFMA32(kf[1], qr[0], zero16); pA0 = MFMA32(kf[2], qr[1], pA0); pA1 = MFMA32(kf[3], qr[1], pA1);
    pA0 = MFMA32(kf[4], qr[2], pA0); pA1 = MFMA32(kf[5], qr[2], pA1); pA0 = MFMA32(kf[6], qr[3], pA0); pA1 = MFMA32(kf[7], qr[3], pA1);
    { const u32x2 mw = *(const LAS u32x2*)(mkp); amask(pA0, pA1, mw.x, mw.y, hi); }
    { const float rm = rowmax(pA0, pA1); mhat = __builtin_fmaxf(rm * C2, MFLOOR); const float nmh = -mhat;
#pragma unroll
      for (int r = 0; r < 16; ++r) { pA0[r] = EX(pA0[r]); pA1[r] = EX(pA1[r]); } }
    WAIT_BAR(0);
    DMA_K(3, 0); DMA_V(1, SLOTB); ROT();
    _Pragma("unroll") for (int d0 = 0; d0 < 4; ++d0) kload2(kf, kp0 + sl_cur, d0);
    WAIT_BAR(2);
#define PKW(P, i) cvtpk(P[i], P[i + 1])
#define PAF(k) __builtin_bit_cast(bf16x8, pw##k)
#define VFR(i) (bf16x8){vlo[i][0], vlo[i][1], vlo[i][2], vlo[i][3], vhi[i][0], vhi[i][1], vhi[i][2], vhi[i][3]}
#define VRD(i) do { vlo[i] = vtr(vp_ + (((i) >> 2) * 4096 + ((i) & 3) * 1024)); vhi[i] = vtr(vp_ + (((i) >> 2) * 4096 + ((i) & 3) * 1024 + 512)); } while (0)
#define KRD(G, d0) do { if (G) { kload2(kf, kp0 + sl_next, d0); SBAR(); } } while (0)
#define GAPA(MF, a0, a1, a2, a3, W0, W1, PW) do { MF; sacc += a0; sacc += a1; sacc += a2; sacc += a3; W0; W1; PIN(PW); PIN(sacc); SBAR(); } while (0)
#define GAPB(MF, X, i) do { MF; X[i] = EX(X[i]); X[i + 1] = EX(X[i + 1]); X[i + 2] = EX(X[i + 2]); X[i + 3] = EX(X[i + 3]); PIN(X); SBAR(); } while (0)
#define STEP(C0, C1, P0, P1, t, GK, GV, GL) do { SBAR(); \
    const lds_cptr vp_ = vp0 + sl_prev; const u32x2 mw_ = *(const LAS u32x2*)(mkp + (t) * 2048); \
    VRD(0); SBAR(); float sacc = P0[0] + P0[1]; \
                    GAPA(C0 = MFMA32(kf[0], qr[0], zero16), P0[2], P0[3], P0[4], P0[5],     pw0[0] = PKW(P0, 0),  pw0[1] = PKW(P0, 2),  pw0); \
    VRD(4); SBAR(); GAPA(C1 = MFMA32(kf[1], qr[0], zero16), P0[6], P0[7], P0[8], P0[9],     pw0[2] = PKW(P0, 4),  pw0[3] = PKW(P0, 6),  pw0); \
    VRD(1); SBAR(); GAPA(C0 = MFMA32(kf[2], qr[1], C0),    P0[10], P0[11], P0[12], P0[13], pw1[0] = PKW(P0, 8),  pw1[1] = PKW(P0, 10), pw1); \
    VRD(5); SBAR(); GAPA(C1 = MFMA32(kf[3], qr[1], C1),    P0[14], P0[15], P1[0], P1[1],   pw1[2] = PKW(P0, 12), pw1[3] = PKW(P0, 14), pw1); \
    VRD(2); SBAR(); GAPA(C0 = MFMA32(kf[4], qr[2], C0),    P1[2], P1[3], P1[4], P1[5],     pw2[0] = PKW(P1, 0),  pw2[1] = PKW(P1, 2),  pw2); \
    VRD(6); SBAR(); GAPA(C1 = MFMA32(kf[5], qr[2], C1),    P1[6], P1[7], P1[8], P1[9],     pw2[2] = PKW(P1, 4),  pw2[3] = PKW(P1, 6),  pw2); \
    VRD(3); SBAR(); GAPA(C0 = MFMA32(kf[6], qr[3], C0),    P1[10], P1[11], P1[12], P1[13], pw3[0] = PKW(P1, 8),  pw3[1] = PKW(P1, 10), pw3); \
    VRD(7); SBAR(); GAPA(C1 = MFMA32(kf[7], qr[3], C1),    P1[14], P1[15], 0.f, 0.f,       pw3[2] = PKW(P1, 12), pw3[3] = PKW(P1, 14), pw3); \
    l_reg += sacc; \
    if (GK) DMA_K((t) + 3, sl_cur); if (GV) DMA_V((t) + 1, sl_next); \
    amask(C0, C1, mw_.x, mw_.y, hi); \
    { const float rm = __builtin_fmaf(rowmax(C0, C1), C2, -mhat); resc = false; \
      if (__builtin_expect(__any(rm > (float)THR), 0)) { const float dl = __builtin_fmaxf(rm, 0.f); mhat += dl; \
          const float f = __builtin_amdgcn_exp2f(-dl); l_reg *= f; if (hi == 0) wsf[r32] = f; resc = true; } } \
    const float nmh = -mhat; SBAR(); \
    GAPB(o[0] = MFMA32(PAF(0), VFR(0), o[0]), C0, 0);              GAPB(o[1] = MFMA32(PAF(0), VFR(4), o[1]), C0, 4); \
    KRD(GL, 0); GAPB(o[0] = MFMA32(PAF(1), VFR(1), o[0]), C0, 8);  KRD(GL, 1); GAPB(o[1] = MFMA32(PAF(1), VFR(5), o[1]), C0, 12); \
    KRD(GL, 2); GAPB(o[0] = MFMA32(PAF(2), VFR(2), o[0]), C1, 0);  KRD(GL, 3); GAPB(o[1] = MFMA32(PAF(2), VFR(6), o[1]), C1, 4); \
    GAPB(o[0] = MFMA32(PAF(3), VFR(3), o[0]), C1, 8);              GAPB(o[1] = MFMA32(PAF(3), VFR(7), o[1]), C1, 12); \
    } while (0)
    int t = 1;
    for (; t + 5 < NT; t += 2) {
        STEP(pB0, pB1, pA0, pA1, t, true, true, true);     WAIT_BAR(2); RESC(); ROT();
        STEP(pA0, pA1, pB0, pB1, t + 1, true, true, true); WAIT_BAR(2); RESC(); ROT();
    }
#define ENDW(tt) do { if ((tt) + 3 < NT) { WAIT_BAR(2); } else if ((tt) + 2 < NT) { WAIT_BAR(1); } else { WAIT_BAR(0); } } while (0)
    for (; t + 1 < NT; t += 2) {
        STEP(pB0, pB1, pA0, pA1, t, (t + 3 < NT), (t + 1 < NT), (t + 1 < NT));         ENDW(t);     RESC(); ROT();
        STEP(pA0, pA1, pB0, pB1, t + 1, (t + 4 < NT), (t + 2 < NT), (t + 2 < NT));     ENDW(t + 1); RESC(); ROT();
    }
    STEP(pB0, pB1, pA0, pA1, NT - 1, false, false, false); RESC();
    { float sacc = pB0[0] + pB0[1];
#pragma unroll
      for (int r = 2; r < 16; ++r) sacc += pB0[r];
#pragma unroll
      for (int r = 0; r < 16; ++r) sacc += pB1[r];
      l_reg += sacc;
      pw0 = (u32x4){PKW(pB0, 0), PKW(pB0, 2), PKW(pB0, 4), PKW(pB0, 6)}; pw1 = (u32x4){PKW(pB0, 8), PKW(pB0, 10), PKW(pB0, 12), PKW(pB0, 14)};
      pw2 = (u32x4){PKW(pB1, 0), PKW(pB1, 2), PKW(pB1, 4), PKW(pB1, 6)}; pw3 = (u32x4){PKW(pB1, 8), PKW(pB1, 10), PKW(pB1, 12), PKW(pB1, 14)};
      const lds_cptr vp_ = vp0 + sl_cur; _Pragma("unroll") for (int i = 0; i < 8; ++i) VRD(i);
      o[0] = MFMA32(PAF(0), VFR(0), o[0]); o[1] = MFMA32(PAF(0), VFR(4), o[1]); o[0] = MFMA32(PAF(1), VFR(1), o[0]); o[1] = MFMA32(PAF(1), VFR(5), o[1]);
      o[0] = MFMA32(PAF(2), VFR(2), o[0]); o[1] = MFMA32(PAF(2), VFR(6), o[1]); o[0] = MFMA32(PAF(3), VFR(3), o[0]); o[1] = MFMA32(PAF(3), VFR(7), o[1]); }
    { auto rr = __builtin_amdgcn_permlane32_swap(__float_as_uint(l_reg), __float_as_uint(l_reg), false, false); l_reg = __uint_as_float(rr[0]) + __uint_as_float(rr[1]); }
    if (hi == 0) wsf[32 + r32] = l_reg; asm volatile("s_waitcnt lgkmcnt(0)" ::: "memory");
    float rli[16];
#pragma unroll
    for (int r = 0; r < 16; ++r) rli[r] = __builtin_amdgcn_rcpf(wsf[32 + crow(r, hi)]);
    bf16_t* Ow = O + (rowbase + q0 + wid * QBLK) * DMO + h * 64; LAS bf16_t* stg = (LAS bf16_t*)(lds + LDS_OST) + wid * 2048;
#pragma unroll
    for (int r = 0; r < 16; ++r) { const int orow = crow(r, hi);
#pragma unroll
        for (int d0 = 0; d0 < 2; ++d0) stg[orow * 64 + d0 * 32 + r32] = (bf16_t)f2bf(o[d0][r] * rli[r]); }
    asm volatile("s_waitcnt lgkmcnt(0)" ::: "memory");
#pragma unroll
    for (int i = 0; i < 4; ++i) { const int row = i * 8 + (lane >> 3), ch = lane & 7; *(u32x4*)(Ow + (long)row * DMO + ch * 8) = *(const LAS u32x4*)(stg + row * 64 + ch * 8); }
    asm volatile("s_waitcnt lgkmcnt(0)\n\ts_barrier" ::: "memory");
#undef DMA_K
#undef DMA_V
#undef ROT
#undef EX
#undef RESC
#undef PKW
#undef PAF
#undef VFR
#undef VRD
#undef KRD
#undef ENDW
#undef GAPA
#undef GAPB
#undef STEP
}
__device__ __forceinline__ void attn_phase(LAS unsigned char* lds, const Bufs& B, const unsigned* MASK, int G, int vcu, bf16_t* Odst) {
    for (int p = vcu; p < NB * NH * 4; p += G) {
        const int b = p >> 5, h = (p >> 2) & 7, j = p & 3;
#pragma unroll 1
        for (int s2 = 0; s2 < 2; ++s2) attn_unit(b, h, s2 ? NQB - 1 - j : j, B.Q, B.K, B.V, MASK, Odst, (LAS char*)lds);
    }
}
#undef SBAR
#undef PIN
#undef MFMA32
#undef WAIT_BAR
#undef MX3
}

__device__ __forceinline__ void pool_phase(LAS unsigned char* lds, const Bufs& B, int G, int vcu) {
    const int tid = threadIdx.x;
    for (int tile = vcu; tile < T / 32; tile += G) {
        const int row0 = tile * 32, t0 = row0 & (S - 1);
        __syncthreads();
        for (int q = tid; q < 47 * 64; q += 512) {
            const int lr = q >> 6, c8 = q & 63, tt = t0 - 15 + lr;
            u32x4 v = {0u, 0u, 0u, 0u};
            if (tt >= 0) v = *(const u32x4*)(B.U + (size_t)(row0 - 15 + lr) * PW + 8 * c8);
            *(LAS u32x4*)(lds + lr * 1024 + c8 * 16) = v;
        }
        __syncthreads();
#pragma unroll
        for (int it = 0; it < 4; ++it) {
            const int item = it * 512 + tid, tl = item >> 6, c8 = item & 63, t = t0 + tl;
            const int win = 2 << (c8 >> 4);
            const int n = (t + 1 < win) ? t + 1 : win;
            f32x4 s0 = {0.f, 0.f, 0.f, 0.f}, s1 = {0.f, 0.f, 0.f, 0.f}, u0, u1;
            { const u32x4 w = *(const LAS u32x4*)(lds + (15 + tl) * 1024 + c8 * 16); unpack8(w, u0, u1); }
            for (int j = 0; j < win; ++j) { f32x4 a, b; const u32x4 w = *(const LAS u32x4*)(lds + (15 + tl - j) * 1024 + c8 * 16); unpack8(w, a, b); s0 += a; s1 += b; }
            const float inv = __builtin_amdgcn_rcpf((float)n);
            *(u32x4*)(B.YC + (size_t)(row0 + tl) * 1024 + 512 + 8 * c8) = pack8(s0 * inv - u0, s1 * inv - u1);
        }
    }
    __syncthreads();
}
__device__ __forceinline__ void router_phase(LAS unsigned char* lds, const float* x2, const float* g2, const float* br, const Bufs& B, int G, int vcu) {
    const int tid = threadIdx.x, lane = tid & 63, wid = __builtin_amdgcn_readfirstlane(tid >> 6), tl = lane & 15, kg = lane >> 4;
    LAS float* lgs = (LAS float*)lds + wid * (16 * 33);
    LAS int* cntl = (LAS int*)(lds + 32768);
    LAS int* basel = cntl + 32;
    LAS int* asg = basel + 32;
    LAS float* gl = (LAS float*)(asg + 512);
    LAS float* rl_ = gl + 512;
    for (int chunk = vcu; chunk < T / 128; chunk += G) {
        if (tid < 32) cntl[tid] = 0;
        __syncthreads();
        const int tok = chunk * 128 + wid * 16 + tl;
        f32x4 acc0 = {0.f, 0.f, 0.f, 0.f}, acc1 = {0.f, 0.f, 0.f, 0.f}; float ss = 0.f;
        const float* xr = x2 + (size_t)tok * D + 8 * kg;
        const bf16_t* wh0 = B.WRH + (size_t)tl * D + 8 * kg; const bf16_t* wl0 = B.WRL + (size_t)tl * D + 8 * kg;
#pragma unroll 2
        for (int ks = 0; ks < 32; ++ks) {
            const f32x4 xa = *(const f32x4*)(xr + 32 * ks), xb = *(const f32x4*)(xr + 32 * ks + 4);
            const f32x4 ga = *(const f32x4*)(g2 + 32 * ks + 8 * kg), gb = *(const f32x4*)(g2 + 32 * ks + 8 * kg + 4);
            ss += xa[0] * xa[0] + xa[1] * xa[1] + xa[2] * xa[2] + xa[3] * xa[3] + xb[0] * xb[0] + xb[1] * xb[1] + xb[2] * xb[2] + xb[3] * xb[3];
            const f32x4 va = xa * ga, vb = xb * gb;
            u32x4 hw, lw;
            {
                unsigned h[8]; float lo[8];
#pragma unroll
                for (int j = 0; j < 4; ++j) { h[j] = f2bf(va[j]); lo[j] = va[j] - bf2f(h[j]); h[4 + j] = f2bf(vb[j]); lo[4 + j] = vb[j] - bf2f(h[4 + j]); }
                hw.x = h[0] | (h[1] << 16); hw.y = h[2] | (h[3] << 16); hw.z = h[4] | (h[5] << 16); hw.w = h[6] | (h[7] << 16);
                lw.x = pk2(lo[0], lo[1]); lw.y = pk2(lo[2], lo[3]); lw.z = pk2(lo[4], lo[5]); lw.w = pk2(lo[6], lo[7]);
            }
            *(u32x2*)(B.H8 + (size_t)tok * D + 32 * ks + 8 * kg) = (u32x2){pk4_fp8(va[0], va[1], va[2], va[3]), pk4_fp8(vb[0], vb[1], vb[2], vb[3])};
            const bf16x8 bh = __builtin_bit_cast(bf16x8, hw), bl = __builtin_bit_cast(bf16x8, lw);
            const bf16x8 ah0 = *(const bf16x8*)(wh0 + 32 * ks), al0 = *(const bf16x8*)(wl0 + 32 * ks);
            const bf16x8 ah1 = *(const bf16x8*)(wh0 + 16 * D + 32 * ks), al1 = *(const bf16x8*)(wl0 + 16 * D + 32 * ks);
            acc0 = __builtin_amdgcn_mfma_f32_16x16x32_bf16(ah0, bh, acc0, 0, 0, 0); acc0 = __builtin_amdgcn_mfma_f32_16x16x32_bf16(ah0, bl, acc0, 0, 0, 0); acc0 = __builtin_amdgcn_mfma_f32_16x16x32_bf16(al0, bh, acc0, 0, 0, 0);
            acc1 = __builtin_amdgcn_mfma_f32_16x16x32_bf16(ah1, bh, acc1, 0, 0, 0); acc1 = __builtin_amdgcn_mfma_f32_16x16x32_bf16(ah1, bl, acc1, 0, 0, 0); acc1 = __builtin_amdgcn_mfma_f32_16x16x32_bf16(al1, bh, acc1, 0, 0, 0);
        }
        ss += __shfl_xor(ss, 16); ss += __shfl_xor(ss, 32);
        const float r = rsqrtf(ss * (1.0f / D) + EPS);
        if (kg == 0) rl_[wid * 16 + tl] = r;
#pragma unroll
        for (int j = 0; j < 4; ++j) { lgs[tl * 33 + 4 * kg + j] = acc0[j] * r + br[4 * kg + j]; lgs[tl * 33 + 16 + 4 * kg + j] = acc1[j] * r + br[16 + 4 * kg + j]; }
        asm volatile("s_waitcnt lgkmcnt(0)" ::: "memory");
        if (lane < 16) {
            LAS float* lv = lgs + lane * 33;
            float v0 = 0.f, sum = 0.f; float ex[TOPK]; int ei[TOPK];
#pragma unroll
            for (int k = 0; k < TOPK; ++k) {
                int bi = 0; float bv = -3.0e38f;
                for (int e = 0; e < NE; ++e) { const float q = lv[e]; if (q > bv) { bv = q; bi = e; } }
                lv[bi] = -3.0e38f;
                if (k == 0) v0 = bv;
                ex[k] = __expf(bv - v0); sum += ex[k]; ei[k] = bi;
            }
            const float inv = 1.0f / sum;
#pragma unroll
            for (int k = 0; k < TOPK; ++k) {
                const int lr = __hip_atomic_fetch_add(&cntl[ei[k]], 1, __ATOMIC_RELAXED, __HIP_MEMORY_SCOPE_WORKGROUP);
                asg[(wid * 16 + lane) * 4 + k] = ei[k] | (lr << 8);
                gl[(wid * 16 + lane) * 4 + k] = ex[k] * inv;
            }
        }
        __syncthreads();
        if (tid < 32) basel[tid] = atomicAdd(&B.CNT[tid], cntl[tid]);
        __syncthreads();
        { const int v = asg[tid], e = v & 255, lr = v >> 8; const size_t pos = (size_t)e * T + basel[e] + lr;
          B.LIST[pos] = (chunk * 128 + (tid >> 2)) * 4 + (tid & 3); B.LISTG[pos] = gl[tid]; B.LISTR[pos] = rl_[tid >> 2]; }
        __syncthreads();
    }
}
__device__ __forceinline__ void combine_phase(float* out, const float* g, const Bufs& B, int G, int vcu) {
    const int lane = threadIdx.x & 63, gw = vcu * 8 + (threadIdx.x >> 6), NGW = G * 8;
    for (int row = gw; row < T; row += NGW) {
        f32x4* xr = (f32x4*)(out + (size_t)row * D) + lane;
        f32x4 v[4]; float s = 0.f;
#pragma unroll
        for (int j = 0; j < 4; ++j) {
            v[j] = xr[64 * j];
#pragma unroll
            for (int k = 0; k < 4; ++k) { const unsigned w = ((const unsigned*)((const fp8_t*)B.Y4 + ((size_t)row * 4 + k) * D))[lane + 64 * j];
                const f32x2 lo = __builtin_amdgcn_cvt_pk_f32_fp8((int)w, false), hi = __builtin_amdgcn_cvt_pk_f32_fp8((int)w, true);
                v[j].x += lo[0] * 0.125f; v[j].y += lo[1] * 0.125f; v[j].z += hi[0] * 0.125f; v[j].w += hi[1] * 0.125f; }
            s += v[j].x * v[j].x + v[j].y * v[j].y + v[j].z * v[j].z + v[j].w * v[j].w;
        }
        const float r = rsqrtf(wave_sum(s) * (1.0f / D) + EPS);
#pragma unroll
        for (int j = 0; j < 4; ++j) { const f32x4 gg = ((const f32x4*)g)[lane + 64 * j]; xr[64 * j] = v[j] * r * gg; }
    }
}

#define XB_TMO      128
#define XB_XCNT(j)  (256  + 64 * (j))
#define XB_XSUB(j)  (1280 + 64 * (j))
#define XB_XGEN(j)  (2304 + 64 * (j))
#define XB_TOP      3328
#define XB_TOPGEN   3392
#define XCD_BAR_WORDS 3456
#define XB_SPIN_CAP (1u << 18)
__device__ __forceinline__ unsigned xb_ld(unsigned* p)              { return __hip_atomic_load(p, __ATOMIC_RELAXED, __HIP_MEMORY_SCOPE_AGENT); }
__device__ __forceinline__ unsigned xb_add(unsigned* p, unsigned v) { return __hip_atomic_fetch_add(p, v, __ATOMIC_RELAXED, __HIP_MEMORY_SCOPE_AGENT); }
__device__ __forceinline__ unsigned xb_xcc_id() { return (unsigned)__builtin_amdgcn_s_getreg((3 << 11) | 20) & 0xFu; }
#define XB_SPIN(cond, bar) do { unsigned _sp = 0; while (cond) { __builtin_amdgcn_s_sleep(1); \
    if ((++_sp & 255u) == 0u) { if (xb_ld(&(bar)[XB_TMO])) break; if (_sp > XB_SPIN_CAP) { atomicAdd(&(bar)[XB_TMO], 1u); break; } } } } while (0)
struct XcdBarrier { unsigned* bar; unsigned x; volatile LAS unsigned* st; };
__device__ __forceinline__ XcdBarrier xcd_barrier_post(unsigned* bar, volatile LAS unsigned* st) {
    XcdBarrier b; b.bar = bar; b.x = xb_xcc_id(); b.st = st;
    if (threadIdx.x == 0) (void)xb_add(&bar[XB_XCNT(b.x)], 1u);
    return b;
}
__device__ __forceinline__ void xcd_barrier_complete(unsigned* bar, unsigned x, unsigned& nloc, unsigned& nx) {
    const unsigned G = gridDim.x * gridDim.y * gridDim.z;
    unsigned sum, cnt, mine, sp = 0u;
    for (;;) {
        sum = 0u; cnt = 0u; mine = 0u;
#pragma unroll
        for (unsigned j = 0; j < 16; ++j) { const unsigned c = xb_ld(&bar[XB_XCNT(j)]); sum += c; cnt += (c > 0u) ? 1u : 0u; mine = (j == x) ? c : mine; }
        if (sum == G) break;
        __builtin_amdgcn_s_sleep(1);
        if ((++sp & 255u) == 0u) { if (xb_ld(&bar[XB_TMO])) break; if (sp > XB_SPIN_CAP) { atomicAdd(&bar[XB_TMO], 1u); break; } }
    }
    nloc = mine > 0u ? mine : 1u; nx = cnt > 0u ? cnt : 1u;
}
__device__ __forceinline__ void xcd_barrier(const XcdBarrier& b) {
    asm volatile("s_waitcnt vmcnt(0)" ::: "memory");
    __syncthreads();
    if (threadIdx.x == 0) {
        unsigned* bar = b.bar;
        __builtin_amdgcn_s_waitcnt(0);
        unsigned nloc = b.st[0], nx = b.st[1];
        if (nloc == 0u) { xcd_barrier_complete(bar, b.x, nloc, nx); b.st[0] = nloc; b.st[1] = nx; }
        const unsigned old = xb_add(&bar[XB_XSUB(b.x)], 1u);
        const unsigned gen = old / nloc;
        if (old + 1u == (gen + 1u) * nloc) {
            __builtin_amdgcn_fence(__ATOMIC_RELEASE, "agent");
            asm volatile("s_waitcnt vmcnt(0)" ::: "memory");
            const unsigned og = xb_add(&bar[XB_TOP], 1u);
            const unsigned tg = og / nx;
            if (og + 1u == (tg + 1u) * nx) xb_add(&bar[XB_TOPGEN], 1u);
            else XB_SPIN(xb_ld(&bar[XB_TOPGEN]) == tg, bar);
            __builtin_amdgcn_fence(__ATOMIC_ACQUIRE, "agent");
            xb_add(&bar[XB_XGEN(b.x)], 1u);
            asm volatile("s_waitcnt vmcnt(0)" ::: "memory");
        } else {
            XB_SPIN(xb_ld(&bar[XB_XGEN(b.x)]) == gen, bar);
            __builtin_amdgcn_fence(__ATOMIC_ACQUIRE, "agent");
            asm volatile("s_waitcnt vmcnt(0)" ::: "memory");
        }
    }
    __syncthreads();
}

enum { PH_PRO = 0, PH_INPROJ = 1, PH_MASK = 2, PH_ATT = 3, PH_UP = 4, PH_OUT = 5, PH_ROUTER = 6, PH_GU = 7, PH_DOWN = 8, PH_COMB = 9, PH_N = 10 };

__global__ void __launch_bounds__(512, 2) mega(Args args) {
    extern __shared__ __attribute__((aligned(16))) unsigned char lds_raw[];
    LAS unsigned char* lds = (LAS unsigned char*)lds_raw;
    const int tid = threadIdx.x, lane = tid & 63, wave = __builtin_amdgcn_readfirstlane(tid >> 6);
    const int G = gridDim.x, bx = blockIdx.x;
    const int vcu = (G % 8 == 0) ? (bx % 8) * (G / 8) + bx / 8 : bx;
    unsigned char* ws = args.ws;
    Bufs B;
    B.HB = (bf16_t*)(ws + WS_HB); B.WIN = (bf16_t*)(ws + WS_WIN); B.WA = (bf16_t*)(ws + WS_WA); B.WC = (bf16_t*)(ws + WS_WC); B.WO = (bf16_t*)(ws + WS_WO);
    B.WGU = (bf16_t*)(ws + WS_WGU); B.WD = (bf16_t*)(ws + WS_WD); B.Q = (bf16_t*)(ws + WS_Q); B.K = (bf16_t*)(ws + WS_K); B.V = (bf16_t*)(ws + WS_V);
    B.IQ = (bf16_t*)(ws + WS_IQ); B.IK = (bf16_t*)(ws + WS_IK); B.U = (bf16_t*)(ws + WS_U); B.SGA = (bf16_t*)(ws + WS_SGA); B.SGP = (bf16_t*)(ws + WS_SGP);
    B.YC = (bf16_t*)(ws + WS_YC); B.YA = (bf16_t*)(ws + WS_YA); B.MX = (bf16_t*)(ws + WS_MX); B.ACT = (bf16_t*)(ws + WS_ACT); B.Y4 = (bf16_t*)(ws + WS_Y4);
    B.IW = (float*)(ws + WS_IW); B.GATE = (float*)(ws + WS_GATE); B.LIST = (int*)(ws + WS_LIST); B.CNT = (int*)(ws + WS_CTL);
    B.WRH = (bf16_t*)(ws + WS_WRH); B.WRL = (bf16_t*)(ws + WS_WRL); B.R2 = (float*)(ws + WS_R2);
    B.H8 = (fp8_t*)(ws + WS_HB); B.WGU8 = (fp8_t*)(ws + WS_WGU); B.WD8 = (fp8_t*)(ws + WS_WD); B.ACT8 = (fp8_t*)(ws + WS_ACT); B.LISTR = (float*)(ws + WS_LISTR); B.LISTG = (float*)(ws + WS_LISTG);
    const float* x = args.in[0]; const float* norm_mix = args.in[1]; const float* w_in = args.in[2]; const float* w_pool = args.in[3]; const float* pool_scale = args.in[4];
    const float* w_attn_up = args.in[5]; const float* w_pool_up = args.in[6]; const float* w_out = args.in[7];
    const float* norm_ffn = args.in[8]; const float* w_router = args.in[9]; const float* b_router = args.in[10];
    const float* w_gate_up = args.in[11]; const float* b_gate_up = args.in[12]; const float* w_down = args.in[13]; const float* b_down = args.in[14]; const float* norm_final = args.in[15];
    const int lo = args.ph_lo, hi = args.ph_hi;
    if (tid < 4) ((LAS unsigned*)(lds + LDS_XB))[tid] = 0u;
    __syncthreads();
    const XcdBarrier xbar = xcd_barrier_post((unsigned*)(ws + WS_CTL) + CW_BAR, (volatile LAS unsigned*)(lds + LDS_XB));
#define IN(k) (lo <= (k) && (k) < hi)
#define SEAM(k) do { if (IN(k) && IN((k) + 1)) { xcd_barrier(xbar); } } while (0)

    if (IN(PH_PRO)) {
        LAS float* scr = (LAS float*)(lds + wave * 16384);
        const int gw = vcu * 8 + wave, NGW = G * 8;
        constexpr int I_IN = (D / 64) * (INP / 32), I_A = (AW / 64) * (D / 32), I_O = (D / 64) * (D / 32), I_GU = (D / 64) * (F2 / 32), I_D = (D / 64) * (D / 32);
        constexpr int NITEMS = I_IN + I_A + I_O + NE * I_GU + NE * I_D;
        for (int it = gw; it < NITEMS; it += NGW) {
            int r = it;
            if (r < I_IN) { transpose_item<1>(w_in, D, INC, B.WIN, scr, r, INP / 32, lane); continue; } r -= I_IN;
            if (r < I_A) { transpose_item<0>(w_attn_up, AW, D, B.WA, scr, r, D / 32, lane); continue; } r -= I_A;
            if (r < I_O) { transpose_item<0>(w_out, D, D, B.WO, scr, r, D / 32, lane); continue; } r -= I_O;
            if (r < NE * I_GU) { const int e = r / I_GU; transpose_item_f8<2>(w_gate_up + (size_t)e * D * F2, D, F2, B.WGU8 + (size_t)e * F2 * D, scr, r % I_GU, F2 / 32, lane); continue; } r -= NE * I_GU;
            { const int e = r / I_D; transpose_item_f8<0>(w_down + (size_t)e * D * D, D, D, B.WD8 + (size_t)e * D * D, scr, r % I_D, D / 32, lane); }
        }
        for (int idx = (vcu * 512 + tid); idx < D * PW; idx += G * 512) {
            const int n = idx & (D - 1), k = idx >> 10, g = k >> 7;
            const float* wp = w_pool + (size_t)k * 128; const float* ps = pool_scale + g * 128; const float* wu = w_pool_up + (size_t)(g * 128) * D + n;
            float a = 0.f;
            for (int d = 0; d < 128; ++d) a = fmaf(wp[d] * ps[d], wu[(size_t)d * D], a);
            B.WC[(size_t)n * PW + k] = (bf16_t)f2bf(a);
        }
        for (int idx = vcu * 512 + tid; idx < NE * D; idx += G * 512) { const int e = idx >> 10, k = idx & (D - 1); const float w = w_router[(size_t)k * NE + e]; const unsigned hh = f2bf(w); B.WRH[idx] = (bf16_t)hh; B.WRL[idx] = (bf16_t)f2bf(w - bf2f(hh)); }
        for (int m = gw; m < T; m += NGW) {
            const f32x4* xr = (const f32x4*)(x + (size_t)m * D) + lane;
            f32x4 v[4]; float s = 0.f;
#pragma unroll
            for (int j = 0; j < 4; ++j) { v[j] = xr[64 * j]; s += v[j].x * v[j].x + v[j].y * v[j].y + v[j].z * v[j].z + v[j].w * v[j].w; }
            const float r = rsqrtf(wave_sum(s) * (1.0f / D) + EPS);
            u32x2* o8 = (u32x2*)(B.HB + (size_t)m * D) + lane;
#pragma unroll
            for (int j = 0; j < 4; ++j) { const f32x4 g = ((const f32x4*)norm_mix)[lane + 64 * j]; u32x2 o; o.x = pk2(v[j].x * r * g.x, v[j].y * r * g.y); o.y = pk2(v[j].z * r * g.z, v[j].w * r * g.w); o8[64 * j] = o; }
        }
    }
    SEAM(PH_PRO);
    if (IN(PH_INPROJ)) {
        pg::StaticOrder So; So.init(T, INP, G, bx, B.HB, D, B.WIN, D);
        EpiInProj E{B};
        pg::gemm_phase<EpiInProj, pg::StaticOrder, false>(lds, D, D, D, So, E);
    }
    SEAM(PH_INPROJ);
    unsigned* MASK = (unsigned*)(ws + WS_MASK);
    if (IN(PH_MASK)) {
        pool_phase(lds, B, G, vcu);
        dsa_mask_phase(lds, B, MASK, G, vcu);
    }
    SEAM(PH_MASK);
    if (IN(PH_ATT)) att::attn_phase(lds, B, MASK, G, vcu, B.YC);
    SEAM(PH_ATT);
    if (IN(PH_UP)) {
        { pg::StaticOrder So; So.init(T, D, G, bx, B.YC, D, B.WA, AW); EpiAttnUp E{B}; pg::gemm_phase<EpiAttnUp, pg::StaticOrder, false>(lds, AW, D, AW, So, E); }
        asm volatile("s_waitcnt vmcnt(0)" ::: "memory"); __syncthreads();
        { pg::StaticOrder So; So.init(T, D, G, bx, B.YC + AW, D, B.WC, PW); EpiPoolUp E{B}; pg::gemm_phase<EpiPoolUp, pg::StaticOrder, false>(lds, PW, D, PW, So, E); }
    }
    SEAM(PH_UP);
    if (IN(PH_OUT)) {
        pg::StaticOrder So; So.init(T, D, G, bx, B.MX, D, B.WO, D);
        EpiOut E{x, args.out};
        pg::gemm_phase<EpiOut, pg::StaticOrder, false>(lds, D, D, D, So, E);
    }
    SEAM(PH_OUT);
    if (IN(PH_ROUTER)) router_phase(lds, args.out, norm_ffn, b_router, B, G, vcu);
    SEAM(PH_ROUTER);
    if (IN(PH_GU)) {
        LAS int* tab = (LAS int*)(lds + LDS_TAB);
        moe_tables(tab, B.CNT, 8);
        MoeOrder Mo; Mo.tab = tab; Mo.NT = 8; Mo.G = G; Mo.c = vcu; Mo.total = tab[NE]; Mo.Abase = (const char*)B.H8; Mo.Bbase = (const char*)B.WGU8; Mo.bexp = (size_t)F2 * D; Mo.list = B.LIST; Mo.dense_a = false;
        Mo.total = __builtin_amdgcn_readfirstlane(Mo.total);
        EpiGateUp E{B.ACT8, b_gate_up, B.LISTR};
        pg::gemm_phase<EpiGateUp, MoeOrder, true, true>(lds, D / 2, D / 2, D / 2, Mo, E);
        __syncthreads();
    }
    SEAM(PH_GU);
    if (IN(PH_DOWN)) {
        LAS int* tab = (LAS int*)(lds + LDS_TAB);
        moe_tables(tab, B.CNT, 4);
        MoeOrder Mo; Mo.tab = tab; Mo.NT = 4; Mo.G = G; Mo.c = vcu; Mo.total = tab[NE]; Mo.Abase = (const char*)B.ACT8; Mo.Bbase = (const char*)B.WD8; Mo.bexp = (size_t)D * D; Mo.list = B.LIST; Mo.dense_a = true;
        Mo.total = __builtin_amdgcn_readfirstlane(Mo.total);
        EpiDown E{(fp8_t*)B.Y4, b_down, B.LISTG, B.LIST};
        pg::gemm_phase<EpiDown, MoeOrder, false, true>(lds, D / 2, D / 2, D / 2, Mo, E);
    }
    SEAM(PH_DOWN);
    if (IN(PH_COMB)) combine_phase(args.out, norm_final, B, G, vcu);
#undef IN
#undef SEAM
}

extern "C" void kernel_launch(void* const* d_in, const int* in_sizes, int n_in, void* d_out, int out_size, void* d_ws, size_t ws_size, hipStream_t stream) {
    static int grid = 0;
    if (grid == 0) {
        if (ws_size < WS_END) { fprintf(stderr, "kernel_launch: workspace too small (%zu < %zu)\n", ws_size, (size_t)WS_END); grid = -1; return; }
        int dev = 0, cus = 0, per_cu = 0;
        (void)hipGetDevice(&dev); (void)hipDeviceGetAttribute(&cus, hipDeviceAttributeMultiprocessorCount, dev);
        (void)hipFuncSetAttribute((const void*)mega, hipFuncAttributeMaxDynamicSharedMemorySize, LDS_BYTES);
        (void)hipOccupancyMaxActiveBlocksPerMultiprocessor(&per_cu, (const void*)mega, 512, LDS_BYTES);
        if (per_cu < 1) { fprintf(stderr, "kernel_launch: occupancy query says %d blocks/CU\n", per_cu); grid = -1; return; }
        grid = cus;
    }
    if (grid < 0) return;
    unsigned char* ws = (unsigned char*)d_ws;
    (void)hipMemsetAsync(ws + WS_CTL, 0, 32768, stream);
    Args a{};
    for (int i = 0; i < 16; ++i) a.in[i] = (const float*)d_in[i];
    a.out = (float*)d_out; a.ws = ws; a.ph_lo = 0; a.ph_hi = PH_N;
    void* kargs[] = {&a};
    hipError_t e = hipLaunchCooperativeKernel((const void*)mega, dim3(grid), dim3(512), kargs, LDS_BYTES, stream);
    if (e != hipSuccess) fprintf(stderr, "kernel_launch: cooperative launch failed: %s (grid %d)\n", hipGetErrorString(e), grid);
}
```

```cpp
#include <hip/hip_runtime.h>
#include <cstdio>
#include <cstdint>

#define LAS __attribute__((address_space(3)))
typedef unsigned short bf16_t;
typedef short bf16x8 __attribute__((ext_vector_type(8)));
typedef float f32x4 __attribute__((ext_vector_type(4)));
typedef float f32x2 __attribute__((ext_vector_type(2)));
typedef unsigned u32x4 __attribute__((ext_vector_type(4)));
typedef unsigned u32x2 __attribute__((ext_vector_type(2)));
typedef int i32x4 __attribute__((ext_vector_type(4)));
typedef int i32x8 __attribute__((ext_vector_type(8)));
typedef unsigned char fp8_t;

constexpr int D = 1024, NB = 16, S = 2048, T = NB * S;
constexpr int NH = 8, HD = 64, AW = 512, NIH = 8, IDD = 32, NKEYS = 256;
constexpr int PW = 512, INC = 3496, INP = 3584;
constexpr int NE = 32, TOPK = 4, F2 = 2048;
constexpr float EPS = 1e-5f;
constexpr int C_Q = 0, C_K = 512, C_V = 576, C_IQ = 640, C_IK = 896, C_IW = 928, C_U = 936, C_GA = 1448, C_GP = 2472;

constexpr size_t MiB = 1u << 20;
constexpr size_t WS_CTL = 0;
constexpr size_t WS_LIST = 1 * MiB;
constexpr size_t WS_GATE = 5 * MiB;
constexpr size_t WS_HB = 8 * MiB;
constexpr size_t WS_WIN = 72 * MiB;
constexpr size_t WS_WA = 79 * MiB;
constexpr size_t WS_WC = 80 * MiB;
constexpr size_t WS_WO = 81 * MiB;
constexpr size_t WS_WGU = 84 * MiB;
constexpr size_t WS_WD = 212 * MiB;
constexpr size_t WS_Q = 276 * MiB;
constexpr size_t WS_K = 308 * MiB;
constexpr size_t WS_V = 312 * MiB;
constexpr size_t WS_IQ = 316 * MiB;
constexpr size_t WS_IK = 332 * MiB;
constexpr size_t WS_IW = 334 * MiB;
constexpr size_t WS_U = 336 * MiB;
constexpr size_t WS_SGA = 368 * MiB;
constexpr size_t WS_SGP = 432 * MiB;
constexpr size_t WS_YC = 496 * MiB;
constexpr size_t WS_YA = 560 * MiB;
constexpr size_t WS_MX = 624 * MiB;
constexpr size_t WS_ACT = 276 * MiB;
constexpr size_t WS_Y4 = 688 * MiB;
constexpr size_t WS_WRH = 6 * MiB;
constexpr size_t WS_WRL = 6 * MiB + 65536;
constexpr size_t WS_R2 = 7 * MiB;
constexpr size_t WS_LISTR = 952 * MiB;
constexpr size_t WS_LISTG = 956 * MiB;
constexpr size_t WS_MASK = 944 * MiB;
constexpr size_t WS_END = 960 * MiB;

__device__ __forceinline__ float bf2f(unsigned b) { return __uint_as_float(b << 16); }
__device__ __forceinline__ unsigned f2bf(float f) { unsigned u = __float_as_uint(f); return (u + 0x7fffu + ((u >> 16) & 1u)) >> 16; }
__device__ __forceinline__ unsigned pk2(float lo, float hi) { return f2bf(lo) | (f2bf(hi) << 16); }
__device__ __forceinline__ unsigned cvt_pk_bf16(float lo, float hi) { unsigned r; asm volatile("v_cvt_pk_bf16_f32 %0, %1, %2" : "=v"(r) : "v"(lo), "v"(hi)); return r; }
__device__ __forceinline__ unsigned pk4_fp8(float a, float b, float c, float d) { int w = __builtin_amdgcn_cvt_pk_fp8_f32(a, b, 0, false); w = __builtin_amdgcn_cvt_pk_fp8_f32(c, d, w, true); return (unsigned)w; }
__device__ __forceinline__ float wave_sum(float v) {
#pragma unroll
    for (int o = 32; o >= 1; o >>= 1) v += __shfl_xor(v, o);
    return v;
}
__device__ __forceinline__ float wave_max(float v) {
#pragma unroll
    for (int o = 32; o >= 1; o >>= 1) v = fmaxf(v, __shfl_xor(v, o));
    return v;
}
__device__ __forceinline__ float sigmoidf_(float x) { return __builtin_amdgcn_rcpf(1.0f + __builtin_amdgcn_exp2f(-1.4426950408889634f * x)); }

namespace pg {
constexpr int BM = 256, BK = 64, HALF = 128, HTB = HALF * BK * 2, STAGE_BYTES = 8 * HTB, NXCD = 8, WGM = 4;
__host__ __device__ __forceinline__ int lds_byte(int r, int c) { const int st = (r >> 4) * 2 + (c >> 5), rr = r & 15, cc = c & 31, ob = rr * 64 + cc * 2; return st * 1024 + (ob ^ (((ob >> 9) & 1) << 5)); }
__host__ __device__ __forceinline__ void stage_rc(int b, int& R, int& C) { const int st = b / 1024, sb = b % 1024, swz = sb ^ (((sb >> 9) & 1) << 5); R = (st >> 1) * 16 + swz / 64; C = (st & 1) * 32 + (swz % 64) / 2; }
__host__ __device__ __forceinline__ int perm32(int rho) { const int n = rho >> 4, i = rho & 15; return 8 * (i >> 2) + 4 * n + (i & 3); }

struct Unit { const char* a; const char* b; const int* rl; int nrows; int pm, pn, e; int lpos; };

struct StaticOrder {
    int nM, nN, nwg, G, c; const char* A; const char* Bt; size_t ta, tb;
    __device__ void init(int M, int N, int G_, int c_, const void* A_, int lda, const void* Bt_, int ldb) { nM = M / BM; nN = N / BM; nwg = nM * nN; G = G_; c = c_; A = (const char*)A_; Bt = (const char*)Bt_; ta = (size_t)BM * lda * 2; tb = (size_t)BM * ldb * 2; }
    __device__ bool next(int i, Unit& u) const {
        const long L = (long)i * G + c; if (L >= nwg) return false;
        int wgid = (int)L; { const int q = nwg / NXCD, r = nwg % NXCD, xcd = wgid % NXCD, off = wgid / NXCD; wgid = (xcd < r ? xcd * (q + 1) : r * (q + 1) + (xcd - r) * q) + off; }
        const int nig = WGM * nN, gid = wgid / nig, fm = gid * WGM, gsz = (nM - fm) < WGM ? (nM - fm) : WGM;
        u.pm = fm + ((wgid % nig) % gsz); u.pn = (wgid % nig) / gsz; u.e = 0; u.nrows = BM; u.rl = nullptr; u.lpos = 0;
        u.a = A + (size_t)u.pm * ta; u.b = Bt + (size_t)u.pn * tb; return true;
    }
};

template <class Epi, class Sched, bool GATHER, bool F8 = false>
__device__ __forceinline__ void gemm_phase(LAS unsigned char* lds, const int K, const int lda, const int ldb, const Sched& S, const Epi& E) {
    const int tid = threadIdx.x, wid = __builtin_amdgcn_readfirstlane(tid >> 6), lane = tid & 63, wr = wid >> 2, wc = wid & 3, fr = lane & 15, fq = lane >> 4;
    const int nt = K / BK;
    unsigned voffB[2], c0[2], c1[2], n0[2], n1[2];
    int Rs[2], Cs[2];
#pragma unroll
    for (int i = 0; i < 2; ++i) { int R, C; stage_rc(tid * 16 + i * 8192, R, C); Rs[i] = R; Cs[i] = C; const int Rb = Epi::PERM ? ((R & ~31) + perm32(R & 31)) : R;
        voffB[i] = (unsigned)(Rb * ldb + C) * 2u; c0[i] = (unsigned)(R * lda + C) * 2u; c1[i] = (unsigned)((R + HALF) * lda + C) * 2u; n0[i] = c0[i]; n1[i] = c1[i]; }
    const size_t kstep = (size_t)(BK * 2);
    const size_t hstepB = (size_t)HALF * ldb * 2;
    const unsigned ldsw = (unsigned)wid * 1024u;
    const int aoff = lds_byte(wr * 64 + fr, fq * 8), boff = lds_byte(wc * 32 + fr, fq * 8);
#define PG_GOFF(u, o0, o1) do { _Pragma("unroll") for (int _i = 0; _i < 2; ++_i) { const int _r0 = Rs[_i], _r1 = Rs[_i] + HALF; \
        const int _t0 = (u).rl[_r0 < (u).nrows ? _r0 : 0] >> 2, _t1 = (u).rl[_r1 < (u).nrows ? _r1 : 0] >> 2; \
        o0[_i] = (unsigned)(_t0 * lda + Cs[_i]) * 2u; o1[_i] = (unsigned)(_t1 * lda + Cs[_i]) * 2u; } } while (0)
#define PG_SA(b, h) (((b) * 2 + (h)) * HTB)
#define PG_SB(b, h) ((4 + (b) * 2 + (h)) * HTB)
#define PG_STAGE(bufoff, gbase, voff) do { _Pragma("unroll") for (int _i = 0; _i < 2; ++_i) \
        __builtin_amdgcn_global_load_lds((const unsigned*)((const char*)(gbase) + (voff)[_i]), (LAS unsigned*)(lds + (bufoff) + ldsw + _i * 8192), 16, 0, 0); } while (0)
#define PG_LDA(dst, b, h) do { _Pragma("unroll") for (int m = 0; m < 4; ++m) _Pragma("unroll") for (int k = 0; k < 2; ++k) dst[m][k] = *(const LAS bf16x8*)(lds + PG_SA(b, h) + aoff + m * 2048 + k * 1024); } while (0)
#define PG_LDB(dst, b, h) do { _Pragma("unroll") for (int n = 0; n < 2; ++n) _Pragma("unroll") for (int k = 0; k < 2; ++k) dst[n][k] = *(const LAS bf16x8*)(lds + PG_SB(b, h) + boff + n * 2048 + k * 1024); } while (0)
#define PG_CAT(x0, x1) __builtin_shufflevector(__builtin_bit_cast(i32x4, x0), __builtin_bit_cast(i32x4, x1), 0, 1, 2, 3, 4, 5, 6, 7)
#define PG_MMA(ai, bj, At, Bt) do { __builtin_amdgcn_s_setprio(1); \
        if constexpr (F8) { _Pragma("unroll") for (int m = 0; m < 4; ++m) _Pragma("unroll") for (int n = 0; n < 2; ++n) \
            asm volatile("v_mfma_scale_f32_16x16x128_f8f6f4 %0, %1, %2, %0, %3, %4 op_sel_hi:[0,0,0]" : "+v"(acc[ai][bj][m][n]) : "v"(PG_CAT(Bt[n][0], Bt[n][1])), "v"(PG_CAT(At[m][0], At[m][1])), "v"(sclW), "v"(sclA)); } \
        else { _Pragma("unroll") for (int m = 0; m < 4; ++m) _Pragma("unroll") for (int n = 0; n < 2; ++n) _Pragma("unroll") for (int k = 0; k < 2; ++k) \
            acc[ai][bj][m][n] = __builtin_amdgcn_mfma_f32_16x16x32_bf16(Bt[n][k], At[m][k], acc[ai][bj][m][n], 0, 0, 0); } \
        __builtin_amdgcn_s_setprio(0); } while (0)
#define PG_WAIT_V(n) asm volatile("s_waitcnt vmcnt(" #n ")" ::: "memory")
#define PG_WAIT_L(n) asm volatile("s_waitcnt lgkmcnt(" #n ")" ::: "memory")
#define PG_BAR __builtin_amdgcn_s_barrier()
#define PG_SCHED __builtin_amdgcn_sched_barrier(0)
    Unit cur, nxt; int ui = 0;
    if (!S.next(0, cur)) return;
    f32x4 acc[2][2][4][2];
#pragma unroll
    for (int a = 0; a < 2; ++a)
#pragma unroll
        for (int b = 0; b < 2; ++b)
#pragma unroll
            for (int m = 0; m < 4; ++m)
#pragma unroll
                for (int n = 0; n < 2; ++n) acc[a][b][m][n] = (f32x4){0.f, 0.f, 0.f, 0.f};
    bf16x8 At[4][2], B0[2][2], B1[2][2];
    int sclW = 0x79797979, sclA = 0x7f7f7f7f;
    asm volatile("" : "+v"(sclW), "+v"(sclA));
    const char* cA = cur.a; const char* cB = cur.b;
    if (GATHER) PG_GOFF(cur, c0, c1);
    PG_STAGE(PG_SB(0, 0), cB, voffB); PG_STAGE(PG_SA(0, 0), cA, c0); PG_STAGE(PG_SB(0, 1), cB + hstepB, voffB); PG_STAGE(PG_SA(0, 1), cA, c1);
    if (wr == 1) PG_BAR;
    PG_WAIT_V(4); PG_BAR;
    PG_STAGE(PG_SB(1, 0), cB + kstep, voffB); PG_STAGE(PG_SA(1, 0), cA + kstep, c0); PG_STAGE(PG_SB(1, 1), cB + hstepB + kstep, voffB);
    PG_WAIT_V(6); PG_BAR;
    for (;;) {
        const bool has_next = S.next(ui + 1, nxt);
        const char* nA = has_next ? nxt.a : cA; const char* nB = has_next ? nxt.b : cB;
        if (GATHER) { if (has_next) PG_GOFF(nxt, n0, n1); else { n0[0] = c0[0]; n0[1] = c0[1]; n1[0] = c1[0]; n1[1] = c1[1]; } }
        for (int t = 0; t < nt; t += 2) {
            const bool last = (t == nt - 2);
            const char* a1 = cA + (size_t)(t + 1) * kstep;
            const char* a2 = last ? nA : cA + (size_t)(t + 2) * kstep; const char* b2 = last ? nB : cB + (size_t)(t + 2) * kstep;
            const char* a3 = a2 + kstep; const char* b3 = b2 + kstep;
            unsigned s0[2], s1[2];
            s0[0] = last ? n0[0] : c0[0]; s0[1] = last ? n0[1] : c0[1]; s1[0] = last ? n1[0] : c1[0]; s1[1] = last ? n1[1] : c1[1];
            PG_LDB(B0, 0, 0); PG_SCHED; PG_LDA(At, 0, 0); PG_STAGE(PG_SA(1, 1), a1, c1);
            PG_WAIT_L(8); PG_BAR; PG_WAIT_L(0); PG_MMA(0, 0, At, B0); PG_BAR; PG_SCHED;
            PG_LDB(B1, 0, 1); PG_STAGE(PG_SB(0, 0), b2, voffB);
            PG_BAR; PG_WAIT_L(0); PG_MMA(0, 1, At, B1); PG_BAR;
            PG_LDA(At, 0, 1); PG_STAGE(PG_SA(0, 0), a2, s0);
            PG_BAR; PG_WAIT_L(0); PG_MMA(1, 0, At, B0); PG_BAR; PG_SCHED;
            PG_STAGE(PG_SB(0, 1), b2 + hstepB, voffB);
            PG_WAIT_V(6); PG_BAR; PG_MMA(1, 1, At, B1); PG_BAR;
            PG_LDB(B0, 1, 0); PG_SCHED; PG_LDA(At, 1, 0); PG_STAGE(PG_SA(0, 1), a2, s1);
            PG_WAIT_L(8); PG_BAR; PG_WAIT_L(0); PG_MMA(0, 0, At, B0); PG_BAR; PG_SCHED;
            PG_LDB(B1, 1, 1); PG_STAGE(PG_SB(1, 0), b3, voffB);
            PG_BAR; PG_WAIT_L(0); PG_MMA(0, 1, At, B1); PG_BAR;
            PG_LDA(At, 1, 1); PG_STAGE(PG_SA(1, 0), a3, s0);
            PG_BAR; PG_WAIT_L(0); PG_MMA(1, 0, At, B0); PG_BAR; PG_SCHED;
            PG_STAGE(PG_SB(1, 1), b3 + hstepB, voffB);
            PG_WAIT_V(6); PG_BAR; PG_MMA(1, 1, At, B1); PG_BAR;
        }
        if constexpr (F8) asm volatile("s_nop 15\n\ts_nop 15" ::: "memory");
        E(acc, cur, wr, wc, fr, fq);
        if (!has_next) break;
#pragma unroll
        for (int a = 0; a < 2; ++a)
#pragma unroll
            for (int b = 0; b < 2; ++b)
#pragma unroll
                for (int m = 0; m < 4; ++m)
#pragma unroll
                    for (int n = 0; n < 2; ++n) acc[a][b][m][n] = (f32x4){0.f, 0.f, 0.f, 0.f};
        cur = nxt; cA = nA; cB = nB; ++ui;
        if (GATHER) { c0[0] = n0[0]; c0[1] = n0[1]; c1[0] = n1[0]; c1[1] = n1[1]; }
    }
    PG_WAIT_V(0);
    if (wr == 0) PG_BAR;
    PG_BAR;
#undef PG_GOFF
#undef PG_SA
#undef PG_SB
#undef PG_STAGE
#undef PG_LDA
#undef PG_LDB
#undef PG_MMA
#undef PG_CAT
#undef PG_WAIT_V
#undef PG_WAIT_L
#undef PG_BAR
#undef PG_SCHED
}
}

struct Bufs {
    bf16_t *HB, *WIN, *WA, *WC, *WO, *WGU, *WD, *Q, *K, *V, *IQ, *IK, *U, *SGA, *SGP, *YC, *YA, *MX, *ACT, *Y4;
    float *IW, *GATE; int* LIST; int* CNT; bf16_t *WRH, *WRL; float* R2;
    fp8_t *H8, *WGU8, *WD8, *ACT8; float *LISTR, *LISTG;
};
__device__ __forceinline__ u32x4 pack8(const f32x4& v0, const f32x4& v1) { u32x4 w; w.x = cvt_pk_bf16(v0[0], v0[1]); w.y = cvt_pk_bf16(v0[2], v0[3]); w.z = cvt_pk_bf16(v1[0], v1[1]); w.w = cvt_pk_bf16(v1[2], v1[3]); return w; }
__device__ __forceinline__ void unpack8(const u32x4& w, f32x4& v0, f32x4& v1) {
    v0[0] = bf2f(w.x & 0xffffu); v0[1] = bf2f(w.x >> 16); v0[2] = bf2f(w.y & 0xffffu); v0[3] = bf2f(w.y >> 16);
    v1[0] = bf2f(w.z & 0xffffu); v1[1] = bf2f(w.z >> 16); v1[2] = bf2f(w.w & 0xffffu); v1[3] = bf2f(w.w >> 16); }

struct EpiInProj {
    static constexpr bool PERM = true;
    Bufs B;
    __device__ __forceinline__ void operator()(const f32x4 (&acc)[2][2][4][2], const pg::Unit& u, int wr, int wc, int fr, int fq) const {
        asm volatile("" : "+v"(fr), "+v"(fq));
        const int pn = u.pn;
        bf16_t* base; int pitch, coff; bool sig = false;
        if (pn < 2) { base = B.Q; pitch = 512; coff = pn * 256; }
        else if (pn == 3) { base = B.IQ; pitch = 256; coff = 0; }
        else if (pn < 6) { base = B.U; pitch = 512; coff = (pn - 4) * 256; }
        else if (pn < 10) { base = B.SGA; pitch = 1024; coff = (pn - 6) * 256; sig = true; }
        else { base = B.SGP; pitch = 1024; coff = (pn - 10) * 256; sig = true; }
#pragma unroll
        for (int ai = 0; ai < 2; ++ai)
#pragma unroll
            for (int m = 0; m < 4; ++m) {
                const size_t row = (size_t)u.pm * 256 + ai * 128 + wr * 64 + m * 16 + fr;
#pragma unroll
                for (int bj = 0; bj < 2; ++bj) {
                    const int cc = bj * 128 + wc * 32 + fq * 8;
                    f32x4 v0 = acc[ai][bj][m][0], v1 = acc[ai][bj][m][1];
                    if (pn == 2) {
                        if (cc < 64) *(u32x4*)(B.K + row * 64 + cc) = pack8(v0, v1);
                        else if (cc < 128) *(u32x4*)(B.V + row * 64 + (cc - 64)) = pack8(v0, v1);
                        else if (cc < 160) *(u32x4*)(B.IK + row * 32 + (cc - 128)) = pack8(v0, v1);
                        else if (cc == 160) { *(f32x4*)(B.IW + row * 8) = v0 * 0.0625f; *(f32x4*)(B.IW + row * 8 + 4) = v1 * 0.0625f; }
                    } else {
                        if (sig) {
#pragma unroll
                            for (int j = 0; j < 4; ++j) { v0[j] = sigmoidf_(v0[j]); v1[j] = sigmoidf_(v1[j]); }
                        }
                        *(u32x4*)(base + row * pitch + coff + cc) = pack8(v0, v1);
                    }
                }
            }
    }
};
#define EPI_PIN4(v) asm volatile("" : "+v"(v))
struct EpiAttnUp {
    static constexpr bool PERM = true;
    Bufs B;
    __device__ __forceinline__ void operator()(const f32x4 (&acc)[2][2][4][2], const pg::Unit& u, int wr, int wc, int fr, int fq) const {
        asm volatile("" : "+v"(fr), "+v"(fq));
        const size_t o0 = ((size_t)u.pm * 256 + wr * 64 + fr) * 1024 + u.pn * 256 + wc * 32 + fq * 8;
        u32x4 g[2][4][2];
#pragma unroll
        for (int ai = 0; ai < 2; ++ai)
#pragma unroll
            for (int m = 0; m < 4; ++m)
#pragma unroll
                for (int bj = 0; bj < 2; ++bj) g[ai][m][bj] = *(const u32x4*)(B.SGA + o0 + (size_t)(ai * 128 + m * 16) * 1024 + bj * 128);
        asm volatile("s_waitcnt vmcnt(0)" ::: "memory");
#pragma unroll
        for (int ai = 0; ai < 2; ++ai)
#pragma unroll
            for (int m = 0; m < 4; ++m)
#pragma unroll
                for (int bj = 0; bj < 2; ++bj) EPI_PIN4(g[ai][m][bj]);
#pragma unroll
        for (int ai = 0; ai < 2; ++ai)
#pragma unroll
            for (int m = 0; m < 4; ++m)
#pragma unroll
                for (int bj = 0; bj < 2; ++bj) {
                    f32x4 g0, g1; unpack8(g[ai][m][bj], g0, g1);
                    *(u32x4*)(B.YA + o0 + (size_t)(ai * 128 + m * 16) * 1024 + bj * 128) = pack8(acc[ai][bj][m][0] * g0, acc[ai][bj][m][1] * g1);
                }
    }
};
struct EpiPoolUp {
    static constexpr bool PERM = true;
    Bufs B;
    __device__ __forceinline__ void operator()(const f32x4 (&acc)[2][2][4][2], const pg::Unit& u, int wr, int wc, int fr, int fq) const {
        asm volatile("" : "+v"(fr), "+v"(fq));
        const size_t o0 = ((size_t)u.pm * 256 + wr * 64 + fr) * 1024 + u.pn * 256 + wc * 32 + fq * 8;
#pragma unroll
        for (int ai = 0; ai < 2; ++ai) {
            u32x4 g[4][2], y[4][2];
#pragma unroll
            for (int m = 0; m < 4; ++m)
#pragma unroll
                for (int bj = 0; bj < 2; ++bj) { const size_t o = o0 + (size_t)(ai * 128 + m * 16) * 1024 + bj * 128; g[m][bj] = *(const u32x4*)(B.SGP + o); y[m][bj] = *(const u32x4*)(B.YA + o); }
            asm volatile("s_waitcnt vmcnt(0)" ::: "memory");
#pragma unroll
            for (int m = 0; m < 4; ++m)
#pragma unroll
                for (int bj = 0; bj < 2; ++bj) { EPI_PIN4(g[m][bj]); EPI_PIN4(y[m][bj]); }
#pragma unroll
            for (int m = 0; m < 4; ++m)
#pragma unroll
                for (int bj = 0; bj < 2; ++bj) {
                    f32x4 g0, g1, y0, y1; unpack8(g[m][bj], g0, g1); unpack8(y[m][bj], y0, y1);
                    *(u32x4*)(B.MX + o0 + (size_t)(ai * 128 + m * 16) * 1024 + bj * 128) = pack8(y0 + acc[ai][bj][m][0] * g0, y1 + acc[ai][bj][m][1] * g1);
                }
        }
    }
};
struct EpiOut {
    static constexpr bool PERM = false;
    const float* x; float* x2;
    __device__ __forceinline__ void operator()(const f32x4 (&acc)[2][2][4][2], const pg::Unit& u, int wr, int wc, int fr, int fq) const {
        asm volatile("" : "+v"(fr), "+v"(fq));
        const size_t o0 = ((size_t)u.pm * 256 + wr * 64 + fr) * 1024 + u.pn * 256 + wc * 32 + fq * 4;
#pragma unroll
        for (int ai = 0; ai < 2; ++ai) {
            f32x4 xv[4][2][2];
#pragma unroll
            for (int m = 0; m < 4; ++m)
#pragma unroll
                for (int bj = 0; bj < 2; ++bj)
#pragma unroll
                    for (int n = 0; n < 2; ++n) xv[m][bj][n] = *(const f32x4*)(x + o0 + (size_t)(ai * 128 + m * 16) * 1024 + bj * 128 + n * 16);
            asm volatile("s_waitcnt vmcnt(0)" ::: "memory");
#pragma unroll
            for (int m = 0; m < 4; ++m)
#pragma unroll
                for (int bj = 0; bj < 2; ++bj)
#pragma unroll
                    for (int n = 0; n < 2; ++n) EPI_PIN4(xv[m][bj][n]);
#pragma unroll
            for (int m = 0; m < 4; ++m)
#pragma unroll
                for (int bj = 0; bj < 2; ++bj)
#pragma unroll
                    for (int n = 0; n < 2; ++n) *(f32x4*)(x2 + o0 + (size_t)(ai * 128 + m * 16) * 1024 + bj * 128 + n * 16) = xv[m][bj][n] + acc[ai][bj][m][n];
        }
    }
};
struct EpiGateUp {
    static constexpr bool PERM = true;
    fp8_t* ACT; const float* bias; const float* LR;
    __device__ __forceinline__ void operator()(const f32x4 (&acc)[2][2][4][2], const pg::Unit& u, int wr, int wc, int fr, int fq) const {
        asm volatile("" : "+v"(fr), "+v"(fq));
        const int ac0 = u.pn * 128 + wc * 32 + fq * 8;
        const float* bp = bias + (size_t)u.e * F2 + 2 * ac0;
        f32x4 bq[4];
#pragma unroll
        for (int j = 0; j < 4; ++j) bq[j] = *(const f32x4*)(bp + 4 * j);
        float rs8[8];
#pragma unroll
        for (int i = 0; i < 8; ++i) { const int rt = (i >> 2) * 128 + wr * 64 + (i & 3) * 16 + fr; rs8[i] = LR[u.lpos + (rt < u.nrows ? rt : 0)]; }
        asm volatile("s_waitcnt vmcnt(0)" ::: "memory");
#pragma unroll
        for (int i = 0; i < 8; ++i) asm volatile("" : "+v"(rs8[i]));
#pragma unroll
        for (int j = 0; j < 4; ++j) asm volatile("" : "+v"(bq[j]));
#pragma unroll
        for (int ai = 0; ai < 2; ++ai)
#pragma unroll
            for (int m = 0; m < 4; ++m) {
                const int rt = ai * 128 + wr * 64 + m * 16 + fr;
                if (rt < u.nrows) {
                    const float rs = rs8[ai * 4 + m];
                    f32x4 o[2];
#pragma unroll
                    for (int n = 0; n < 2; ++n)
#pragma unroll
                        for (int jp = 0; jp < 2; ++jp) {
                            const int c = 4 * n + 2 * jp;
                            const f32x2 ag = {acc[ai][0][m][n][2 * jp], acc[ai][0][m][n][2 * jp + 1]}, au = {acc[ai][1][m][n][2 * jp], acc[ai][1][m][n][2 * jp + 1]};
                            const f32x2 bg = {bq[c >> 1][(c & 1) * 2], bq[(c + 1) >> 1][((c + 1) & 1) * 2]}, bu = {bq[c >> 1][(c & 1) * 2 + 1], bq[(c + 1) >> 1][((c + 1) & 1) * 2 + 1]};
                            f32x2 g = ag * rs + bg, uu = au * rs + bu;
                            g.x = fminf(g.x, 7.0f); g.y = fminf(g.y, 7.0f);
                            uu.x = __builtin_amdgcn_fmed3f(uu.x, -7.0f, 7.0f); uu.y = __builtin_amdgcn_fmed3f(uu.y, -7.0f, 7.0f);
                            const f32x2 t = g * (-1.702f * 1.4426950408889634f);
                            f32x2 e; e.x = __builtin_amdgcn_exp2f(t.x); e.y = __builtin_amdgcn_exp2f(t.y);
                            const f32x2 d = e + 1.0f;
                            f32x2 sg; sg.x = __builtin_amdgcn_rcpf(d.x); sg.y = __builtin_amdgcn_rcpf(d.y);
                            const f32x2 gs = g * sg, r2 = uu * gs + gs;
                            o[n][2 * jp] = r2.x; o[n][2 * jp + 1] = r2.y;
                        }
                    *(u32x2*)(ACT + ((size_t)u.pm * 256 + rt) * 1024 + ac0) = (u32x2){pk4_fp8(o[0][0], o[0][1], o[0][2], o[0][3]), pk4_fp8(o[1][0], o[1][1], o[1][2], o[1][3])};
                }
            }
    }
};
struct EpiDown {
    static constexpr bool PERM = true;
    fp8_t* Y4; const float* bias; const float* gates; const int* LI;
    __device__ __forceinline__ void operator()(const f32x4 (&acc)[2][2][4][2], const pg::Unit& u, int wr, int wc, int fr, int fq) const {
        asm volatile("" : "+v"(fr), "+v"(fq));
        f32x4 bq[2][2];
#pragma unroll
        for (int bj = 0; bj < 2; ++bj) { const float* bp = bias + (size_t)u.e * 1024 + u.pn * 256 + bj * 128 + wc * 32 + fq * 8; bq[bj][0] = *(const f32x4*)bp; bq[bj][1] = *(const f32x4*)(bp + 4); }
        int a8[8]; float g8[8];
#pragma unroll
        for (int i = 0; i < 8; ++i) { const int rt = (i >> 2) * 128 + wr * 64 + (i & 3) * 16 + fr; const int q = u.lpos + (rt < u.nrows ? rt : 0); a8[i] = LI[q]; g8[i] = gates[q]; }
        asm volatile("s_waitcnt vmcnt(0)" ::: "memory");
#pragma unroll
        for (int i = 0; i < 8; ++i) asm volatile("" : "+v"(a8[i]), "+v"(g8[i]));
#pragma unroll
        for (int bj = 0; bj < 2; ++bj) asm volatile("" : "+v"(bq[bj][0]), "+v"(bq[bj][1]));
#pragma unroll
        for (int ai = 0; ai < 2; ++ai)
#pragma unroll
            for (int m = 0; m < 4; ++m) {
                const int rt = ai * 128 + wr * 64 + m * 16 + fr;
                if (rt < u.nrows) {
                    const int a = a8[ai * 4 + m]; const float gt = g8[ai * 4 + m] * 8.0f;
#pragma unroll
                    for (int bj = 0; bj < 2; ++bj) {
                        const f32x4 y0 = (acc[ai][bj][m][0] + bq[bj][0]) * gt, y1 = (acc[ai][bj][m][1] + bq[bj][1]) * gt;
                        *(u32x2*)(Y4 + (size_t)a * 1024 + u.pn * 256 + bj * 128 + wc * 32 + fq * 8) = (u32x2){pk4_fp8(y0[0], y0[1], y0[2], y0[3]), pk4_fp8(y1[0], y1[1], y1[2], y1[3])};
                    }
                }
            }
    }
};

struct MoeOrder {
    const LAS int* tab; int NT, G, c, total; const char* Abase; const char* Bbase; size_t bexp; const int* list; bool dense_a;
    __device__ bool next(int i, pg::Unit& u) const {
        const long L = (long)i * G + c; if (L >= total) return false;
        int e = 0;
        for (int j = 1; j < NE; ++j) e += (tab[j] <= (int)L) ? 1 : 0;
        e = __builtin_amdgcn_readfirstlane(e);
        const int l = (int)L - __builtin_amdgcn_readfirstlane(tab[e]), rt = l / NT, pn = l - rt * NT;
        const int cnt = __builtin_amdgcn_readfirstlane(tab[64 + e]), ro = __builtin_amdgcn_readfirstlane(tab[128 + e]);
        u.e = e; u.pn = pn; u.pm = ro + rt; u.nrows = (cnt - rt * 256) < 256 ? (cnt - rt * 256) : 256;
        u.rl = list + (size_t)e * T + rt * 256; u.lpos = e * T + rt * 256;
        u.a = dense_a ? Abase + (size_t)(ro + rt) * 256 * 1024 : Abase;
        u.b = Bbase + (size_t)e * bexp + (size_t)pn * 256 * 1024;
        return true;
    }
};

__device__ __forceinline__ int inproj_src(int n) {
    if (n < 512) return C_Q + n;
    if (n < 576) return C_K + (n - 512);
    if (n < 640) return C_V + (n - 576);
    if (n < 672) return C_IK + (n - 640);
    if (n < 680) return C_IW + (n - 672);
    if (n < 768) return -1;
    if (n < 1024) return C_IQ + (n - 768);
    if (n < 1536) return C_U + (n - 1024);
    if (n < 2560) return C_GA + (n - 1536);
    return C_GP + (n - 2560);
}
template <int MODE> __device__ __forceinline__ void transpose_item(const float* W, int K, int N, bf16_t* WT, LAS float* scr, int item, int nblk, int lane) {
    const int kb = item / nblk, nb = item % nblk, k0 = 64 * kb, n0 = 32 * nb;
    const int nd = n0 + (lane & 31);
    int sc;
    if (MODE == 0) sc = nd; else if (MODE == 1) sc = inproj_src(nd); else { const int p = nd >> 8, bj = (nd >> 7) & 1, i = nd & 127; sc = 2 * (128 * p + i) + bj; }
#pragma unroll 8
    for (int i = 0; i < 32; ++i) { const int kk = 2 * i + (lane >> 5); scr[kk * 33 + (lane & 31)] = (sc >= 0) ? W[(size_t)(k0 + kk) * N + sc] : 0.f; }
    asm volatile("s_waitcnt lgkmcnt(0)" ::: "memory");
    const int c = lane & 7;
#pragma unroll
    for (int j = 0; j < 4; ++j) { const int n = (lane >> 3) + 8 * j; const LAS float* s = scr + (8 * c) * 33 + n;
        u32x4 o; o.x = pk2(s[0 * 33], s[1 * 33]); o.y = pk2(s[2 * 33], s[3 * 33]); o.z = pk2(s[4 * 33], s[5 * 33]); o.w = pk2(s[6 * 33], s[7 * 33]);
        *(u32x4*)(WT + (size_t)(n0 + n) * K + k0 + 8 * c) = o; }
    asm volatile("s_waitcnt lgkmcnt(0)" ::: "memory");
}

template <int MODE> __device__ __forceinline__ void transpose_item_f8(const float* W, int K, int N, fp8_t* WT, LAS float* scr, int item, int nblk, int lane) {
    const int kb = item / nblk, nb = item % nblk, k0 = 64 * kb, n0 = 32 * nb;
    const int nd = n0 + (lane & 31);
    int sc;
    if (MODE == 0) sc = nd; else { const int p = nd >> 8, bj = (nd >> 7) & 1, i = nd & 127; sc = 2 * (128 * p + i) + bj; }
    float v[32];
#pragma unroll
    for (int i = 0; i < 32; ++i) v[i] = W[(size_t)(k0 + 2 * i + (lane >> 5)) * N + sc];
#pragma unroll
    for (int i = 0; i < 32; ++i) scr[(2 * i + (lane >> 5)) * 33 + (lane & 31)] = v[i] * 64.0f;
    asm volatile("s_waitcnt lgkmcnt(0)" ::: "memory");
    const int c = lane & 3;
#pragma unroll
    for (int j = 0; j < 2; ++j) { const int n = (lane >> 2) + 16 * j; const LAS float* s = scr + (16 * c) * 33 + n;
        u32x4 o; o.x = pk4_fp8(s[0 * 33], s[1 * 33], s[2 * 33], s[3 * 33]); o.y = pk4_fp8(s[4 * 33], s[5 * 33], s[6 * 33], s[7 * 33]);
        o.z = pk4_fp8(s[8 * 33], s[9 * 33], s[10 * 33], s[11 * 33]); o.w = pk4_fp8(s[12 * 33], s[13 * 33], s[14 * 33], s[15 * 33]);
        *(u32x4*)(WT + (size_t)(n0 + n) * K + k0 + 16 * c) = o; }
    asm volatile("s_waitcnt lgkmcnt(0)" ::: "memory");
}

struct Args {
    const float* in[16]; float* out; unsigned char* ws; int ph_lo, ph_hi;
};

constexpr int LDS_XB = 151552 - 64;
constexpr int CW_BAR = 1024;
constexpr int LDS_TAB = pg::STAGE_BYTES;
constexpr int LDS_BYTES = 151552;

__device__ __forceinline__ void moe_tables(LAS int* tab, const int* cnt_g, int NT) {
    if (threadIdx.x < 64) {
        const int lane = threadIdx.x;
        const int c = lane < NE ? __hip_atomic_load(cnt_g + lane, __ATOMIC_RELAXED, __HIP_MEMORY_SCOPE_AGENT) : 0;
        const int rt = (c + 255) >> 8;
        int pre = rt;
#pragma unroll
        for (int o = 1; o < 64; o <<= 1) { const int v = __shfl_up(pre, o); if (lane >= o) pre += v; }
        const int excl = pre - rt;
        if (lane < NE) { tab[lane] = excl * NT; tab[64 + lane] = c; tab[128 + lane] = excl; }
        if (lane == NE) { tab[NE] = excl * NT; tab[128 + NE] = excl; }
    }
    __syncthreads();
}


typedef float f32x16 __attribute__((ext_vector_type(16)));
__device__ __forceinline__ int wave_total_le32(int c) {
    int tot = 0;
#pragma unroll
    for (int b = 0; b < 6; ++b) tot += __builtin_popcountll(__ballot((c >> b) & 1)) << b;
    return tot;
}
__device__ __forceinline__ unsigned ord_key(float f) { const unsigned u = __float_as_uint(f); return u ^ ((unsigned)((int)u >> 31) | 0x80000000u); }
template <int CTRL> __device__ __forceinline__ float dppf(float v) { return __int_as_float(__builtin_amdgcn_update_dpp(0, __float_as_int(v), CTRL, 0xf, 0xf, true)); }
__device__ __forceinline__ float wave_max_u(float v) {
    v = fmaxf(v, dppf<0xB1>(v)); v = fmaxf(v, dppf<0x4E>(v)); v = fmaxf(v, dppf<0x141>(v)); v = fmaxf(v, dppf<0x140>(v));
    const int b = __float_as_int(v);
    return fmaxf(fmaxf(__int_as_float(__builtin_amdgcn_readlane(b, 0)), __int_as_float(__builtin_amdgcn_readlane(b, 16))), fmaxf(__int_as_float(__builtin_amdgcn_readlane(b, 32)), __int_as_float(__builtin_amdgcn_readlane(b, 48))));
}
__device__ __forceinline__ int wave_incl_scan(int v) {
    v += __builtin_amdgcn_update_dpp(0, v, 0x111, 0xf, 0xf, false);
    v += __builtin_amdgcn_update_dpp(0, v, 0x112, 0xf, 0xf, false);
    v += __builtin_amdgcn_update_dpp(0, v, 0x114, 0xf, 0xf, false);
    v += __builtin_amdgcn_update_dpp(0, v, 0x118, 0xf, 0xf, false);
    v += __builtin_amdgcn_update_dpp(0, v, 0x142, 0xa, 0xf, false);
    v += __builtin_amdgcn_update_dpp(0, v, 0x143, 0xc, 0xf, false);
    return v;
}
__device__ __forceinline__ unsigned select_word(const float (&x)[32], unsigned vm, int lane, LAS int* hist, LAS float* cval, const LAS float* srow) {
    unsigned active = vm, sel = 0u; int need = NKEYS;
    for (;;) {
        float mnn = -__builtin_inff(), mxx = -__builtin_inff();
#pragma unroll
        for (int i = 0; i < 32; ++i) { const bool a = (active >> i) & 1u; mnn = a ? fmaxf(mnn, -x[i]) : mnn; mxx = a ? fmaxf(mxx, x[i]) : mxx; }
        const float mn = -wave_max_u(mnn), mx = wave_max_u(mxx);
        const float scale = 256.0f / (mx - mn);
        if (!(scale < 1.0e37f)) {
            if (mn == mx) {
                const int c = __builtin_popcount(active); const int incl = wave_incl_scan(c);
                int allow = need - (incl - c);
#pragma unroll
                for (int i = 0; i < 32; ++i) { const bool a = (active >> i) & 1u; if (a && allow > 0) sel |= 1u << i; if (a) --allow; }
                return sel;
            }
            const unsigned kmax = ord_key(mx); const unsigned span = kmax - ord_key(mn); const int nbits = 32 - __builtin_clz(span); const int shift = nbits > 6 ? nbits - 6 : 0;
            *(LAS f32x4*)(hist + 4 * lane) = (f32x4){0.f, 0.f, 0.f, 0.f};
#pragma unroll
            for (int i = 0; i < 32; ++i) { const int b = (int)((kmax - ord_key(x[i])) >> shift); __hip_atomic_fetch_add(&hist[((active >> i) & 1u) ? b : 255], (int)((active >> i) & 1u), __ATOMIC_RELAXED, __HIP_MEMORY_SCOPE_WAVEFRONT); }
            const int h = hist[lane];
            const int incl = wave_incl_scan(h);
            const int Ls = __builtin_ctzll(__ballot(incl >= need));
            const int above = __builtin_amdgcn_readlane(incl, Ls) - __builtin_amdgcn_readlane(h, Ls), cnt = __builtin_amdgcn_readlane(h, Ls);
            unsigned na = 0u;
#pragma unroll
            for (int i = 0; i < 32; ++i) { const int b = (int)((kmax - ord_key(x[i])) >> shift); const unsigned bit = active & (1u << i); sel |= (b < Ls) ? bit : 0u; na |= (b == Ls) ? bit : 0u; }
            active = na; need -= above;
            if (cnt <= 64) break;
            continue;
        }
        *(LAS f32x4*)(hist + 4 * lane) = (f32x4){0.f, 0.f, 0.f, 0.f};
#pragma unroll
        for (int i = 0; i < 32; ++i) {
            int b = (int)((mx - x[i]) * scale); b = b < 0 ? 0 : (b > 255 ? 255 : b);
            __hip_atomic_fetch_add(&hist[b], (int)((active >> i) & 1u), __ATOMIC_RELAXED, __HIP_MEMORY_SCOPE_WAVEFRONT);
        }
        const int h0 = hist[4 * lane], h1 = hist[4 * lane + 1], h2 = hist[4 * lane + 2], h3 = hist[4 * lane + 3];
        const int L = h0 + h1 + h2 + h3, incl = wave_incl_scan(L);
        const int Ls = __builtin_ctzll(__ballot(incl >= need));
        int c = __builtin_amdgcn_readlane(incl, Ls) - __builtin_amdgcn_readlane(L, Ls);
        const int g0 = __builtin_amdgcn_readlane(h0, Ls), g1 = __builtin_amdgcn_readlane(h1, Ls), g2 = __builtin_amdgcn_readlane(h2, Ls), g3 = __builtin_amdgcn_readlane(h3, Ls);
        int Bs = 4 * Ls, cnt = g0;
        if (c + g0 < need) { c += g0; Bs += 1; cnt = g1; if (c + g1 < need) { c += g1; Bs += 1; cnt = g2; if (c + g2 < need) { c += g2; Bs += 1; cnt = g3; } } }
        const float fB = (float)Bs, fB1 = (float)(Bs + 1);
        unsigned na = 0u;
#pragma unroll
        for (int i = 0; i < 32; ++i) {
            const float q = (mx - x[i]) * scale; const unsigned bit = active & (1u << i);
            const bool lt = q < fB, inb = (q >= fB) && (q < fB1 || Bs == 255);
            sel |= lt ? bit : 0u; na |= inb ? bit : 0u;
        }
        active = na; need -= c;
        if (cnt <= 64) break;
    }
    LAS f32x2* cv2 = (LAS f32x2*)cval;
    const int cmine = __builtin_popcount(active);
    int pos = wave_incl_scan(cmine) - cmine;
    const int base = __builtin_amdgcn_readlane(pos, 63) + __builtin_amdgcn_readlane(cmine, 63);
    {
        unsigned rem = active;
        while (__ballot(rem != 0u) != 0ull) {
            if (rem != 0u) { const int i = __builtin_ctz(rem); rem &= rem - 1u; cv2[pos++] = (f32x2){srow[32 * lane + i], __int_as_float(32 * lane + i)}; }
        }
    }
    const int m = base, me = lane < m ? lane : 0;
    const f32x2 mine = cv2[me]; const float v = mine.x; const int id = __float_as_int(mine.y);
    int rank = 0;
    for (int u = 0; u < m; ++u) { const f32x2 o = cv2[u]; const int iu = __float_as_int(o.y); rank += (o.x > v || (o.x == v && iu < id)) ? 1 : 0; }
    const unsigned long long hit = __ballot(lane < m && rank == need - 1);
    const int src = __builtin_ctzll(hit);
    const float P = __int_as_float(__builtin_amdgcn_readlane(__float_as_int(v), src)); const int Pidx = __builtin_amdgcn_readlane(id, src);
#pragma unroll
    for (int i = 0; i < 32; ++i) { const unsigned bit = active & (1u << i); sel |= (x[i] > P || (x[i] == P && 32 * lane + i <= Pidx)) ? bit : 0u; }
    return sel;
}
__device__ __forceinline__ void dsa_mask_phase(LAS unsigned char* lds, const Bufs& B, unsigned* MASK, int G, int vcu) {
    LAS float* sc = (LAS float*)lds;
    const int tid = threadIdx.x, lane = tid & 63, wid = __builtin_amdgcn_readfirstlane(tid >> 6), r32 = lane & 31, hi = lane >> 5;
    const int npairs = NB * 64;
    for (int pr = vcu; pr < npairs; pr += G) {
        for (int s2 = 0; s2 < 2; ++s2) {
            const int b = pr >> 6, kk = pr & 63, ti = s2 ? 127 - kk : kk;
            const int t0 = ti * 16, row0 = b * S + t0, nkb = (t0 + 16 + 31) >> 5;
            bf16x8 af[4][2];
            {
                const int a = r32 >> 4, bb = (r32 >> 3) & 1, c = (r32 >> 2) & 1, d = r32 & 3;
                const int tokl = 2 * c + a, head = 4 * bb + d;
#pragma unroll
                for (int rb = 0; rb < 4; ++rb)
#pragma unroll
                    for (int ks = 0; ks < 2; ++ks) af[rb][ks] = *(const bf16x8*)(B.IQ + (size_t)(row0 + 4 * rb + tokl) * 256 + head * 32 + 16 * ks + 8 * hi);
            }
            LAS float* wl = (LAS float*)(lds + 147456);
            __syncthreads();
            if (tid < 128) wl[tid] = B.IW[(size_t)row0 * 8 + tid];
            __syncthreads();
            for (int kb = wid; kb < nkb; kb += 8) {
                const int key = 32 * kb + r32;
                const bf16x8 bf0 = *(const bf16x8*)(B.IK + (size_t)(b * S + key) * 32 + 8 * hi);
                const bf16x8 bf1 = *(const bf16x8*)(B.IK + (size_t)(b * S + key) * 32 + 16 + 8 * hi);
#pragma unroll
                for (int rb = 0; rb < 4; ++rb) {
                    f32x16 acc = {};
                    acc = __builtin_amdgcn_mfma_f32_32x32x16_bf16(af[rb][0], bf0, acc, 0, 0, 0);
                    acc = __builtin_amdgcn_mfma_f32_32x32x16_bf16(af[rb][1], bf1, acc, 0, 0, 0);
#pragma unroll
                    for (int a = 0; a < 2; ++a) {
                        float sv = 0.f;
#pragma unroll
                        for (int bb = 0; bb < 2; ++bb)
                        { const f32x4 wv = *(const LAS f32x4*)(wl + (4 * rb + 2 * hi + a) * 8 + 4 * bb);
#pragma unroll
                            for (int d = 0; d < 4; ++d) sv = fmaf(wv[d], fmaxf(acc[8 * a + 4 * bb + d], 0.f), sv); }
                        sc[(4 * rb + 2 * hi + a) * 2048 + key] = sv;
                    }
                }
            }
            __syncthreads();
#pragma unroll 1
            for (int qq = 0; qq < 2; ++qq) {
                const int ql = 2 * wid + qq, t = t0 + ql, nk = t + 1;
                unsigned word;
                const int kbase = 32 * lane;
                const int nb = t - kbase + 1;
                const unsigned vm = nb >= 32 ? 0xffffffffu : (nb <= 0 ? 0u : ((1u << nb) - 1u));
                if (nk <= NKEYS) word = vm;
                else {
                    float xv[32];
#pragma unroll
                    for (int j = 0; j < 8; ++j) {
                        const f32x4 v = *(const LAS f32x4*)(sc + ql * 2048 + kbase + 4 * j);
                        xv[4 * j] = v[0]; xv[4 * j + 1] = v[1]; xv[4 * j + 2] = v[2]; xv[4 * j + 3] = v[3];
                    }
                    word = select_word(xv, vm, lane, (LAS int*)(lds + 131072 + wid * 2048), (LAS float*)(lds + 131072 + wid * 2048 + 1024), sc + ql * 2048);
                }
                MASK[(size_t)(row0 + ql) * 64 + lane] = word;
            }
        }
    }
    __syncthreads();
}

namespace att {
typedef short s16x4 __attribute__((ext_vector_type(4)));
typedef short v4i16_t __attribute__((ext_vector_type(4)));
constexpr int NW = 8, QBLK = 32, QB = QBLK * NW, KVBLK = 64, NQB = S / QB, DMQ = 512, DMK = 64, DMO = 1024;
constexpr float C2 = 0.125f * 1.4426950408889634f;
constexpr float NEGM = -1.0e30f, MFLOOR = -1.0e5f;
constexpr int THR = 8;
constexpr int SLOTB = 8192, LDS_K = 0, LDS_V = 3 * SLOTB, LDS_WS = 6 * SLOTB, LDS_OST = LDS_WS + NW * 256, LDS_MK = LDS_OST + NW * 4096, LDS_END = LDS_MK + 32 * 2048;
#define SBAR() __builtin_amdgcn_sched_barrier(0)
#define PIN(x) asm volatile("" : "+v"(x))
#define MFMA32(a, b, c) __builtin_amdgcn_mfma_f32_32x32x16_bf16(a, b, c, 0, 0, 0)
#define WAIT_BAR(N) asm volatile("s_waitcnt vmcnt(" #N ") lgkmcnt(0)\n\ts_barrier" ::: "memory")
__device__ __forceinline__ int crow(int r, int hi) { return (r & 3) + 8 * (r >> 2) + 4 * hi; }
__device__ __forceinline__ unsigned cvtpk(float lo, float hi) { unsigned r; asm("v_cvt_pk_bf16_f32 %0, %1, %2" : "=v"(r) : "v"(lo), "v"(hi)); return r; }
__device__ __forceinline__ void glds16(const void* g, unsigned lds_base) {
    unsigned sv; asm volatile("s_mov_b32 %0, m0\n\ts_mov_b32 m0, %2\n\ts_nop 0\n\tglobal_load_lds_dwordx4 %1, off\n\ts_mov_b32 m0, %0" : "=&s"(sv) : "v"(g), "s"(lds_base) : "memory"); }
typedef LAS const char* lds_cptr;
__device__ __forceinline__ void kload2(bf16x8* kf, lds_cptr kp, int d0) { kf[2 * d0] = *(const LAS bf16x8*)(kp + d0 * 2048); kf[2 * d0 + 1] = *(const LAS bf16x8*)(kp + d0 * 2048 + 512); }
__device__ __forceinline__ s16x4 vtr(lds_cptr p) { return __builtin_bit_cast(s16x4, __builtin_amdgcn_ds_read_tr16_b64_v4i16((LAS v4i16_t*)p)); }
#define MX3(a, b, c) __builtin_fmaxf(__builtin_fmaxf((a), (b)), (c))
__device__ __forceinline__ float rowmax(const f32x16& p0, const f32x16& p1) {
    float a = MX3(p0[0], p0[1], p1[0]), b = MX3(p0[2], p0[3], p1[1]); a = MX3(a, p1[2], p1[3]);
#pragma unroll
    for (int r = 4; r < 16; r += 4) { a = MX3(a, p0[r], p0[r + 1]); b = MX3(b, p0[r + 2], p0[r + 3]); a = MX3(a, p1[r], p1[r + 1]); b = MX3(b, p1[r + 2], p1[r + 3]); }
    float m = __builtin_fmaxf(a, b); auto rr = __builtin_amdgcn_permlane32_swap(__float_as_uint(m), __float_as_uint(m), false, false);
    return __builtin_fmaxf(__uint_as_float(rr[0]), __uint_as_float(rr[1])); }
__device__ __forceinline__ void amask(f32x16& p0, f32x16& p1, unsigned w0, unsigned w1, int hi) {
    const unsigned a = w0 >> (4 * hi), b = w1 >> (4 * hi);
#pragma unroll
    for (int r = 0; r < 16; ++r) { const int bit = (r & 3) + 8 * (r >> 2); if (!((a >> bit) & 1u)) p0[r] = NEGM; if (!((b >> bit) & 1u)) p1[r] = NEGM; } }

__device__ __forceinline__ void attn_unit(int b, int h, int qb, const bf16_t* Q, const bf16_t* __restrict__ K, const bf16_t* __restrict__ V, const unsigned* __restrict__ MASK, bf16_t* O, LAS char* lds) {
    const int tid = threadIdx.x, lane = tid & 63, r32 = lane & 31, hi = lane >> 5; const int wid = __builtin_amdgcn_readfirstlane(tid >> 6);
    const long rowbase = (long)b * S; const int q0 = qb * QB, NT = (q0 + QB) / KVBLK;
    const bf16_t* Qw = Q + (rowbase + q0 + wid * QBLK) * DMQ + h * 64;
    const unsigned lds0 = (unsigned)(uintptr_t)lds; LAS float* wsf = (LAS float*)(lds + LDS_WS) + wid * 64;
    {
        const unsigned* mrow = MASK + (size_t)(rowbase + q0 + (tid >> 1)) * 64 + (tid & 1) * 32;
        u32x4 mv[8];
#pragma unroll
        for (int j = 0; j < 8; ++j) mv[j] = *(const u32x4*)(mrow + 4 * j);
#pragma unroll
        for (int j = 0; j < 8; ++j) {
            const int tl = (tid & 1) * 16 + 2 * j;
            *(LAS u32x2*)(lds + LDS_MK + tl * 2048 + (tid >> 1) * 8) = (u32x2){mv[j].x, mv[j].y};
            *(LAS u32x2*)(lds + LDS_MK + (tl + 1) * 2048 + (tid >> 1) * 8) = (u32x2){mv[j].z, mv[j].w};
        }
    }
    const LAS char* mkp = lds + LDS_MK + (wid * QBLK + r32) * 8;
    const bf16_t* ksrc = K + rowbase * DMK + (long)lane * DMK + wid * 8;
    const bf16_t* vsrc = V + rowbase * DMK + (long)(16 * (wid & 3) + (lane >> 2)) * DMK + (wid >> 2) * 32 + (lane & 3) * 8;
    const unsigned kdst = lds0 + LDS_K + wid * 1024, vdst = lds0 + LDS_V + wid * 1024;
#define DMA_K(t, slot) glds16(ksrc + (long)(t) * KVBLK * DMK, (unsigned)__builtin_amdgcn_readfirstlane(kdst + (slot)))
#define DMA_V(t, slot) glds16(vsrc + (long)(t) * KVBLK * DMK, (unsigned)__builtin_amdgcn_readfirstlane(vdst + (slot)))
    const lds_cptr vp0 = (lds_cptr)lds + LDS_V + ((lane >> 4) & 1) * 32 + (lane & 3) * 8 + (4 * hi + ((lane & 15) >> 2)) * 64;
    const lds_cptr kp0 = (lds_cptr)lds + LDS_K + hi * 1024 + r32 * 16;
    asm volatile("s_waitcnt vmcnt(0)" ::: "memory");
    DMA_K(0, 0); DMA_V(0, 0); DMA_K(1, SLOTB);
    bf16x8 qr[4];
#pragma unroll
    for (int d0 = 0; d0 < 4; ++d0) qr[d0] = *reinterpret_cast<const bf16x8*>(&Qw[(long)r32 * DMQ + d0 * 16 + hi * 8]);
    float mhat = 0.f, l_reg = 0.f; f32x16 o[2]; o[0] = f32x16{}; o[1] = f32x16{};
    const f32x16 zero16 = f32x16{};
    bool resc = false;
    f32x16 pA0, pA1, pB0, pB1; bf16x8 kf[8]; s16x4 vlo[8], vhi[8]; u32x4 pw0, pw1, pw2, pw3;
    int sl_prev = 0, sl_cur = 0, sl_next = SLOTB;
#define ROT() do { sl_prev = sl_cur; sl_cur = sl_next; sl_next = (sl_next == 2 * SLOTB) ? 0 : sl_next + SLOTB; } while (0)
#define EX(v) __builtin_amdgcn_exp2f(__builtin_fmaf((v), C2, nmh))
#define RESC() do { if (resc) { _Pragma("unroll") for (int d_ = 0; d_ < 2; ++d_) _Pragma("unroll") for (int r = 0; r < 16; ++r) o[d_][r] *= wsf[crow(r, hi)]; } } while (0)
    DMA_K(2, 2 * SLOTB);
    WAIT_BAR(3);
    _Pragma("unroll") for (int d0 = 0; d0 < 4; ++d0) kload2(kf, kp0, d0);
    pA0 = MFMA32(kf[0], qr[0], zero16); pA1 = MFMA32(kf[1], qr[0], zero16); pA0 = MFMA32(kf[2], qr[1], pA0); pA1 = MFMA32(kf[3], qr[1], pA1);
    pA0 = MFMA32(kf[4], qr[2], pA0); pA1 = MFMA32(kf[5], qr[2], pA1); pA0 = MFMA32(kf[6], qr[3], pA0); pA1 = MFMA32(kf[7], qr[3], pA1);
    { const u32x2 mw = *(const LAS u32x2*)(mkp); amask(pA0, pA1, mw.x, mw.y, hi); }
    { const float rm = rowmax(pA0, pA1); mhat = __builtin_fmaxf(rm * C2, MFLOOR); const float nmh = -mhat;
#pragma unroll
      for (int r = 0; r < 16; ++r) { pA0[r] = EX(pA0[r]); pA1[r] = EX(pA1[r]); } }
    WAIT_BAR(0);
    DMA_K(3, 0); DMA_V(1, SLOTB); ROT();
    _Pragma("unroll") for (int d0 = 0; d0 < 4; ++d0) kload2(kf, kp0 + sl_cur, d0);
    WAIT_BAR(2);
#define PKW(P, i) cvtpk(P[i], P[i + 1])
#define PAF(k) __builtin_bit_cast(bf16x8, pw##k)
#define VFR(i) (bf16x8){vlo[i][0], vlo[i][1], vlo[i][2], vlo[i][3], vhi[i][0], vhi[i][1], vhi[i][2], vhi[i][3]}
#define VRD(i) do { vlo[i] = vtr(vp_ + (((i) >> 2) * 4096 + ((i) & 3) * 1024)); vhi[i] = vtr(vp_ + (((i) >> 2) * 4096 + ((i) & 3) * 1024 + 512)); } while (0)
#define KRD(G, d0) do { if (G) { kload2(kf, kp0 + sl_next, d0); SBAR(); } } while (0)
#define GAPA(MF, a0, a1, a2, a3, W0, W1, PW) do { MF; sacc += a0; sacc += a1; sacc += a2; sacc += a3; W0; W1; PIN(PW); PIN(sacc); SBAR(); } while (0)
#define GAPB(MF, X, i) do { MF; X[i] = EX(X[i]); X[i + 1] = EX(X[i + 1]); X[i + 2] = EX(X[i + 2]); X[i + 3] = EX(X[i + 3]); PIN(X); SBAR(); } while (0)
#define STEP(C0, C1, P0, P1, t, GK, GV, GL) do { SBAR(); \
    const lds_cptr vp_ = vp0 + sl_prev; const u32x2 mw_ = *(const LAS u32x2*)(mkp + (t) * 2048); \
    VRD(0); SBAR(); float sacc = P0[0] + P0[1]; \
                    GAPA(C0 = MFMA32(kf[0], qr[0], zero16), P0[2], P0[3], P0[4], P0[5],     pw0[0] = PKW(P0, 0),  pw0[1] = PKW(P0, 2),  pw0); \
    VRD(4); SBAR(); GAPA(C1 = MFMA32(kf[1], qr[0], zero16), P0[6], P0[7], P0[8], P0[9],     pw0[2] = PKW(P0, 4),  pw0[3] = PKW(P0, 6),  pw0); \
    VRD(1); SBAR(); GAPA(C0 = MFMA32(kf[2], qr[1], C0),    P0[10], P0[11], P0[12], P0[13], pw1[0] = PKW(P0, 8),  pw1[1] = PKW(P0, 10), pw1); \
    VRD(5); SBAR(); GAPA(C1 = MFMA32(kf[3], qr[1], C1),    P0[14], P0[15], P1[0], P1[1],   pw1[2] = PKW(P0, 12), pw1[3] = PKW(P0, 14), pw1); \
    VRD(2); SBAR(); GAPA(C0 = MFMA32(kf[4], qr[2], C0),    P1[2], P1[3], P1[4], P1[5],     pw2[0] = PKW(P1, 0),  pw2[1] = PKW(P1, 2),  pw2); \
    VRD(6); SBAR(); GAPA(C1 = MFMA32(kf[5], qr[2], C1),    P1[6], P1[7], P1[8], P1[9],     pw2[2] = PKW(P1, 4),  pw2[3] = PKW(P1, 6),  pw2); \
    VRD(3); SBAR(); GAPA(C0 = MFMA32(kf[6], qr[3], C0),    P1[10], P1[11], P1[12], P1[13], pw3[0] = PKW(P1, 8),  pw3[1] = PKW(P1, 10), pw3); \
    VRD(7); SBAR(); GAPA(C1 = MFMA32(kf[7], qr[3], C1),    P1[14], P1[15], 0.f, 0.f,       pw3[2] = PKW(P1, 12), pw3[3] = PKW(P1, 14), pw3); \
    l_reg += sacc; \
    if (GK) DMA_K((t) + 3, sl_cur); if (GV) DMA_V((t) + 1, sl_next); \
    amask(C0, C1, mw_.x, mw_.y, hi); \
    { const float rm = __builtin_fmaf(rowmax(C0, C1), C2, -mhat); resc = false; \
      if (__builtin_expect(__any(rm > (float)THR), 0)) { const float dl = __builtin_fmaxf(rm, 0.f); mhat += dl; \
          const float f = __builtin_amdgcn_exp2f(-dl); l_reg *= f; if (hi == 0) wsf[r32] = f; resc = true; } } \
    const float nmh = -mhat; SBAR(); \
    GAPB(o[0] = MFMA32(PAF(0), VFR(0), o[0]), C0, 0);              GAPB(o[1] = MFMA32(PAF(0), VFR(4), o[1]), C0, 4); \
    KRD(GL, 0); GAPB(o[0] = MFMA32(PAF(1), VFR(1), o[0]), C0, 8);  KRD(GL, 1); GAPB(o[1] = MFMA32(PAF(1), VFR(5), o[1]), C0, 12); \
    KRD(GL, 2); GAPB(o[0] = MFMA32(PAF(2), VFR(2), o[0]), C1, 0);  KRD(GL, 3); GAPB(o[1] = MFMA32(PAF(2), VFR(6), o[1]), C1, 4); \
    GAPB(o[0] = MFMA32(PAF(3), VFR(3), o[0]), C1, 8);              GAPB(o[1] = MFMA32(PAF(3), VFR(7), o[1]), C1, 12); \
    } while (0)
    int t = 1;
    for (; t + 5 < NT; t += 2) {
        STEP(pB0, pB1, pA0, pA1, t, true, true, true);     WAIT_BAR(2); RESC(); ROT();
        STEP(pA0, pA1, pB0, pB1, t + 1, true, true, true); WAIT_BAR(2); RESC(); ROT();
    }
#define ENDW(tt) do { if ((tt) + 3 < NT) { WAIT_BAR(2); } else if ((tt) + 2 < NT) { WAIT_BAR(1); } else { WAIT_BAR(0); } } while (0)
    for (; t + 1 < NT; t += 2) {
        STEP(pB0, pB1, pA0, pA1, t, (t + 3 < NT), (t + 1 < NT), (t + 1 < NT));         ENDW(t);     RESC(); ROT();
        STEP(pA0, pA1, pB0, pB1, t + 1, (t + 4 < NT), (t + 2 < NT), (t + 2 < NT));     ENDW(t + 1); RESC(); ROT();
    }
    STEP(pB0, pB1, pA0, pA1, NT - 1, false, false, false); RESC();
    { float sacc = pB0[0] + pB0[1];
#pragma unroll
      for (int r = 2; r < 16; ++r) sacc += pB0[r];
#pragma unroll
      for (int r = 0; r < 16; ++r) sacc += pB1[r];
      l_reg += sacc;
      pw0 = (u32x4){PKW(pB0, 0), PKW(pB0, 2), PKW(pB0, 4), PKW(pB0, 6)}; pw1 = (u32x4){PKW(pB0, 8), PKW(pB0, 10), PKW(pB0, 12), PKW(pB0, 14)};
      pw2 = (u32x4){PKW(pB1, 0), PKW(pB1, 2), PKW(pB1, 4), PKW(pB1, 6)}; pw3 = (u32x4){PKW(pB1, 8), PKW(pB1, 10), PKW(pB1, 12), PKW(pB1, 14)};
      const lds_cptr vp_ = vp0 + sl_cur; _Pragma("unroll") for (int i = 0; i < 8; ++i) VRD(i);
      o[0] = MFMA32(PAF(0), VFR(0), o[0]); o[1] = MFMA32(PAF(0), VFR(4), o[1]); o[0] = MFMA32(PAF(1), VFR(1), o[0]); o[1] = MFMA32(PAF(1), VFR(5), o[1]);
      o[0] = MFMA32(PAF(2), VFR(2), o[0]); o[1] = MFMA32(PAF(2), VFR(6), o[1]); o[0] = MFMA32(PAF(3), VFR(3), o[0]); o[1] = MFMA32(PAF(3), VFR(7), o[1]); }
    { auto rr = __builtin_amdgcn_permlane32_swap(__float_as_uint(l_reg), __float_as_uint(l_reg), false, false); l_reg = __uint_as_float(rr[0]) + __uint_as_float(rr[1]); }
    if (hi == 0) wsf[32 + r32] = l_reg; asm volatile("s_waitcnt lgkmcnt(0)" ::: "memory");
    float rli[16];
#pragma unroll
    for (int r = 0; r < 16; ++r) rli[r] = __builtin_amdgcn_rcpf(wsf[32 + crow(r, hi)]);
    bf16_t* Ow = O + (rowbase + q0 + wid * QBLK) * DMO + h * 64; LAS bf16_t* stg = (LAS bf16_t*)(lds + LDS_OST) + wid * 2048;
#pragma unroll
    for (int r = 0; r < 16; ++r) { const int orow = crow(r, hi);
#pragma unroll
        for (int d0 = 0; d0 < 2; ++d0) stg[orow * 64 + d0 * 32 + r32] = (bf16_t)f2bf(o[d0][r] * rli[r]); }
    asm volatile("s_waitcnt lgkmcnt(0)" ::: "memory");
#pragma unroll
    for (int i = 0; i < 4; ++i) { const int row = i * 8 + (lane >> 3), ch = lane & 7; *(u32x4*)(Ow + (long)row * DMO + ch * 8) = *(const LAS u32x4*)(stg + row * 64 + ch * 8); }
    asm volatile("s_waitcnt lgkmcnt(0)\n\ts_barrier" ::: "memory");
#undef DMA_K
#undef DMA_V
#undef ROT
#undef EX
#undef RESC
#undef PKW
#undef PAF
#undef VFR
#undef VRD
#undef KRD
#undef ENDW
#undef GAPA
#undef GAPB
#undef STEP
}
__device__ __forceinline__ void attn_phase(LAS unsigned char* lds, const Bufs& B, const unsigned* MASK, int G, int vcu, bf16_t* Odst) {
    for (int p = vcu; p < NB * NH * 4; p += G) {
        const int b = p >> 5, h = (p >> 2) & 7, j = p & 3;
#pragma unroll 1
        for (int s2 = 0; s2 < 2; ++s2) attn_unit(b, h, s2 ? NQB - 1 - j : j, B.Q, B.K, B.V, MASK, Odst, (LAS char*)lds);
    }
}
#undef SBAR
#undef PIN
#undef MFMA32
#undef WAIT_BAR
#undef MX3
}

__device__ __forceinline__ void pool_phase(LAS unsigned char* lds, const Bufs& B, int G, int vcu) {
    const int tid = threadIdx.x;
    for (int tile = vcu; tile < T / 32; tile += G) {
        const int row0 = tile * 32, t0 = row0 & (S - 1);
        __syncthreads();
        for (int q = tid; q < 47 * 64; q += 512) {
            const int lr = q >> 6, c8 = q & 63, tt = t0 - 15 + lr;
            u32x4 v = {0u, 0u, 0u, 0u};
            if (tt >= 0) v = *(const u32x4*)(B.U + (size_t)(row0 - 15 + lr) * PW + 8 * c8);
            *(LAS u32x4*)(lds + lr * 1024 + c8 * 16) = v;
        }
        __syncthreads();
#pragma unroll
        for (int it = 0; it < 4; ++it) {
            const int item = it * 512 + tid, tl = item >> 6, c8 = item & 63, t = t0 + tl;
            const int win = 2 << (c8 >> 4);
            const int n = (t + 1 < win) ? t + 1 : win;
            f32x4 s0 = {0.f, 0.f, 0.f, 0.f}, s1 = {0.f, 0.f, 0.f, 0.f}, u0, u1;
            { const u32x4 w = *(const LAS u32x4*)(lds + (15 + tl) * 1024 + c8 * 16); unpack8(w, u0, u1); }
            for (int j = 0; j < win; ++j) { f32x4 a, b; const u32x4 w = *(const LAS u32x4*)(lds + (15 + tl - j) * 1024 + c8 * 16); unpack8(w, a, b); s0 += a; s1 += b; }
            const float inv = __builtin_amdgcn_rcpf((float)n);
            *(u32x4*)(B.YC + (size_t)(row0 + tl) * 1024 + 512 + 8 * c8) = pack8(s0 * inv - u0, s1 * inv - u1);
        }
    }
    __syncthreads();
}
__device__ __forceinline__ void router_phase(LAS unsigned char* lds, const float* x2, const float* g2, const float* br, const Bufs& B, int G, int vcu) {
    const int tid = threadIdx.x, lane = tid & 63, wid = __builtin_amdgcn_readfirstlane(tid >> 6), tl = lane & 15, kg = lane >> 4;
    LAS float* lgs = (LAS float*)lds + wid * (16 * 33);
    LAS int* cntl = (LAS int*)(lds + 32768);
    LAS int* basel = cntl + 32;
    LAS int* asg = basel + 32;
    LAS float* gl = (LAS float*)(asg + 512);
    LAS float* rl_ = gl + 512;
    for (int chunk = vcu; chunk < T / 128; chunk += G) {
        if (tid < 32) cntl[tid] = 0;
        __syncthreads();
        const int tok = chunk * 128 + wid * 16 + tl;
        f32x4 acc0 = {0.f, 0.f, 0.f, 0.f}, acc1 = {0.f, 0.f, 0.f, 0.f}; float ss = 0.f;
        const bf16_t* wh0 = B.WRH + (size_t)tl * D + 8 * kg; const bf16_t* wl0 = B.WRL + (size_t)tl * D + 8 * kg;
        LAS float* xt = (LAS float*)(lds + 40960 + wid * 8448);
        const float* xsrc = x2 + (size_t)(chunk * 128 + wid * 16 + (lane >> 5)) * D + 4 * (lane & 31);
        f32x4 xa_[8], xb_[8];
#pragma unroll
        for (int i = 0; i < 8; ++i) xa_[i] = *(const f32x4*)(xsrc + (size_t)(2 * i) * D);
#define ROUTER_CHUNK(CUR, NXT, c) do { \
            if ((c) + 1 < 8) { _Pragma("unroll") for (int i = 0; i < 8; ++i) NXT[i] = *(const f32x4*)(xsrc + (size_t)(2 * i) * D + 128 * ((c) + 1)); } \
            _Pragma("unroll") for (int i = 0; i < 8; ++i) *(LAS f32x4*)(xt + (2 * i + (lane >> 5)) * 132 + 4 * (lane & 31)) = CUR[i]; \
            asm volatile("s_waitcnt lgkmcnt(0)" ::: "memory"); \
            _Pragma("unroll") for (int k4 = 0; k4 < 4; ++k4) { const int ks = 4 * (c) + k4; \
                const f32x4 xa = *(const LAS f32x4*)(xt + tl * 132 + 32 * k4 + 8 * kg), xb = *(const LAS f32x4*)(xt + tl * 132 + 32 * k4 + 8 * kg + 4); \
                const f32x4 ga = *(const f32x4*)(g2 + 32 * ks + 8 * kg), gb = *(const f32x4*)(g2 + 32 * ks + 8 * kg + 4); \
                ss += xa[0] * xa[0] + xa[1] * xa[1] + xa[2] * xa[2] + xa[3] * xa[3] + xb[0] * xb[0] + xb[1] * xb[1] + xb[2] * xb[2] + xb[3] * xb[3]; \
                const f32x4 va = xa * ga, vb = xb * gb; \
                u32x4 hw, lw; \
                { unsigned h[8]; float lo[8]; \
                  _Pragma("unroll") for (int j = 0; j < 4; ++j) { h[j] = f2bf(va[j]); lo[j] = va[j] - bf2f(h[j]); h[4 + j] = f2bf(vb[j]); lo[4 + j] = vb[j] - bf2f(h[4 + j]); } \
                  hw.x = h[0] | (h[1] << 16); hw.y = h[2] | (h[3] << 16); hw.z = h[4] | (h[5] << 16); hw.w = h[6] | (h[7] << 16); \
                  lw.x = pk2(lo[0], lo[1]); lw.y = pk2(lo[2], lo[3]); lw.z = pk2(lo[4], lo[5]); lw.w = pk2(lo[6], lo[7]); } \
                *(u32x2*)(B.H8 + (size_t)tok * D + 32 * ks + 8 * kg) = (u32x2){pk4_fp8(va[0], va[1], va[2], va[3]), pk4_fp8(vb[0], vb[1], vb[2], vb[3])}; \
                const bf16x8 bh = __builtin_bit_cast(bf16x8, hw), bl = __builtin_bit_cast(bf16x8, lw); \
                const bf16x8 ah0 = *(const bf16x8*)(wh0 + 32 * ks), al0 = *(const bf16x8*)(wl0 + 32 * ks); \
                const bf16x8 ah1 = *(const bf16x8*)(wh0 + 16 * D + 32 * ks), al1 = *(const bf16x8*)(wl0 + 16 * D + 32 * ks); \
                acc0 = __builtin_amdgcn_mfma_f32_16x16x32_bf16(ah0, bh, acc0, 0, 0, 0); acc0 = __builtin_amdgcn_mfma_f32_16x16x32_bf16(ah0, bl, acc0, 0, 0, 0); acc0 = __builtin_amdgcn_mfma_f32_16x16x32_bf16(al0, bh, acc0, 0, 0, 0); \
                acc1 = __builtin_amdgcn_mfma_f32_16x16x32_bf16(ah1, bh, acc1, 0, 0, 0); acc1 = __builtin_amdgcn_mfma_f32_16x16x32_bf16(ah1, bl, acc1, 0, 0, 0); acc1 = __builtin_amdgcn_mfma_f32_16x16x32_bf16(al1, bh, acc1, 0, 0, 0); } \
            asm volatile("s_waitcnt lgkmcnt(0)" ::: "memory"); } while (0)
#pragma unroll 1
        for (int c2 = 0; c2 < 8; c2 += 2) { ROUTER_CHUNK(xa_, xb_, c2); ROUTER_CHUNK(xb_, xa_, c2 + 1); }
#undef ROUTER_CHUNK
        ss += __shfl_xor(ss, 16); ss += __shfl_xor(ss, 32);
        const float r = rsqrtf(ss * (1.0f / D) + EPS);
        if (kg == 0) rl_[wid * 16 + tl] = r;
#pragma unroll
        for (int j = 0; j < 4; ++j) { lgs[tl * 33 + 4 * kg + j] = acc0[j] * r + br[4 * kg + j]; lgs[tl * 33 + 16 + 4 * kg + j] = acc1[j] * r + br[16 + 4 * kg + j]; }
        asm volatile("s_waitcnt lgkmcnt(0)" ::: "memory");
        if (lane < 16) {
            LAS float* lv = lgs + lane * 33;
            float v0 = 0.f, sum = 0.f; float ex[TOPK]; int ei[TOPK];
#pragma unroll
            for (int k = 0; k < TOPK; ++k) {
                int bi = 0; float bv = -3.0e38f;
                for (int e = 0; e < NE; ++e) { const float q = lv[e]; if (q > bv) { bv = q; bi = e; } }
                lv[bi] = -3.0e38f;
                if (k == 0) v0 = bv;
                ex[k] = __expf(bv - v0); sum += ex[k]; ei[k] = bi;
            }
            const float inv = 1.0f / sum;
#pragma unroll
            for (int k = 0; k < TOPK; ++k) {
                const int lr = __hip_atomic_fetch_add(&cntl[ei[k]], 1, __ATOMIC_RELAXED, __HIP_MEMORY_SCOPE_WORKGROUP);
                asg[(wid * 16 + lane) * 4 + k] = ei[k] | (lr << 8);
                gl[(wid * 16 + lane) * 4 + k] = ex[k] * inv;
            }
        }
        __syncthreads();
        if (tid < 32) basel[tid] = atomicAdd(&B.CNT[tid], cntl[tid]);
        __syncthreads();
        { const int v = asg[tid], e = v & 255, lr = v >> 8; const size_t pos = (size_t)e * T + basel[e] + lr;
          B.LIST[pos] = (chunk * 128 + (tid >> 2)) * 4 + (tid & 3); B.LISTG[pos] = gl[tid]; B.LISTR[pos] = rl_[tid >> 2]; }
        __syncthreads();
    }
}
__device__ __forceinline__ void combine_phase(float* out, const float* g, const Bufs& B, int G, int vcu) {
    const int lane = threadIdx.x & 63, gw = vcu * 8 + (threadIdx.x >> 6), NGW = G * 8;
    for (int row = gw; row < T; row += NGW) {
        f32x4* xr = (f32x4*)(out + (size_t)row * D) + lane;
        f32x4 v[4]; float s = 0.f;
#pragma unroll
        for (int j = 0; j < 4; ++j) {
            v[j] = xr[64 * j];
#pragma unroll
            for (int k = 0; k < 4; ++k) { const unsigned w = ((const unsigned*)((const fp8_t*)B.Y4 + ((size_t)row * 4 + k) * D))[lane + 64 * j];
                const f32x2 lo = __builtin_amdgcn_cvt_pk_f32_fp8((int)w, false), hi = __builtin_amdgcn_cvt_pk_f32_fp8((int)w, true);
                v[j].x += lo[0] * 0.125f; v[j].y += lo[1] * 0.125f; v[j].z += hi[0] * 0.125f; v[j].w += hi[1] * 0.125f; }
            s += v[j].x * v[j].x + v[j].y * v[j].y + v[j].z * v[j].z + v[j].w * v[j].w;
        }
        const float r = rsqrtf(wave_sum(s) * (1.0f / D) + EPS);
#pragma unroll
        for (int j = 0; j < 4; ++j) { const f32x4 gg = ((const f32x4*)g)[lane + 64 * j]; xr[64 * j] = v[j] * r * gg; }
    }
}

#define XB_TMO      128
#define XB_XCNT(j)  (256  + 64 * (j))
#define XB_XSUB(j)  (1280 + 64 * (j))
#define XB_XGEN(j)  (2304 + 64 * (j))
#define XB_TOP      3328
#define XB_TOPGEN   3392
#define XCD_BAR_WORDS 3456
#define XB_SPIN_CAP (1u << 18)
__device__ __forceinline__ unsigned xb_ld(unsigned* p)              { return __hip_atomic_load(p, __ATOMIC_RELAXED, __HIP_MEMORY_SCOPE_AGENT); }
__device__ __forceinline__ unsigned xb_add(unsigned* p, unsigned v) { return __hip_atomic_fetch_add(p, v, __ATOMIC_RELAXED, __HIP_MEMORY_SCOPE_AGENT); }
__device__ __forceinline__ unsigned xb_xcc_id() { return (unsigned)__builtin_amdgcn_s_getreg((3 << 11) | 20) & 0xFu; }
#define XB_SPIN(cond, bar) do { unsigned _sp = 0; while (cond) { __builtin_amdgcn_s_sleep(1); \
    if ((++_sp & 255u) == 0u) { if (xb_ld(&(bar)[XB_TMO])) break; if (_sp > XB_SPIN_CAP) { atomicAdd(&(bar)[XB_TMO], 1u); break; } } } } while (0)
struct XcdBarrier { unsigned* bar; unsigned x; volatile LAS unsigned* st; };
__device__ __forceinline__ XcdBarrier xcd_barrier_post(unsigned* bar, volatile LAS unsigned* st) {
    XcdBarrier b; b.bar = bar; b.x = xb_xcc_id(); b.st = st;
    if (threadIdx.x == 0) (void)xb_add(&bar[XB_XCNT(b.x)], 1u);
    return b;
}
__device__ __forceinline__ void xcd_barrier_complete(unsigned* bar, unsigned x, unsigned& nloc, unsigned& nx) {
    const unsigned G = gridDim.x * gridDim.y * gridDim.z;
    unsigned sum, cnt, mine, sp = 0u;
    for (;;) {
        sum = 0u; cnt = 0u; mine = 0u;
#pragma unroll
        for (unsigned j = 0; j < 16; ++j) { const unsigned c = xb_ld(&bar[XB_XCNT(j)]); sum += c; cnt += (c > 0u) ? 1u : 0u; mine = (j == x) ? c : mine; }
        if (sum == G) break;
        __builtin_amdgcn_s_sleep(1);
        if ((++sp & 255u) == 0u) { if (xb_ld(&bar[XB_TMO])) break; if (sp > XB_SPIN_CAP) { atomicAdd(&bar[XB_TMO], 1u); break; } }
    }
    nloc = mine > 0u ? mine : 1u; nx = cnt > 0u ? cnt : 1u;
}
__device__ __forceinline__ void xcd_barrier(const XcdBarrier& b) {
    asm volatile("s_waitcnt vmcnt(0)" ::: "memory");
    __syncthreads();
    if (threadIdx.x == 0) {
        unsigned* bar = b.bar;
        __builtin_amdgcn_s_waitcnt(0);
        unsigned nloc = b.st[0], nx = b.st[1];
        if (nloc == 0u) { xcd_barrier_complete(bar, b.x, nloc, nx); b.st[0] = nloc; b.st[1] = nx; }
        const unsigned old = xb_add(&bar[XB_XSUB(b.x)], 1u);
        const unsigned gen = old / nloc;
        if (old + 1u == (gen + 1u) * nloc) {
            __builtin_amdgcn_fence(__ATOMIC_RELEASE, "agent");
            asm volatile("s_waitcnt vmcnt(0)" ::: "memory");
            const unsigned og = xb_add(&bar[XB_TOP], 1u);
            const unsigned tg = og / nx;
            if (og + 1u == (tg + 1u) * nx) xb_add(&bar[XB_TOPGEN], 1u);
            else XB_SPIN(xb_ld(&bar[XB_TOPGEN]) == tg, bar);
            __builtin_amdgcn_fence(__ATOMIC_ACQUIRE, "agent");
            xb_add(&bar[XB_XGEN(b.x)], 1u);
            asm volatile("s_waitcnt vmcnt(0)" ::: "memory");
        } else {
            XB_SPIN(xb_ld(&bar[XB_XGEN(b.x)]) == gen, bar);
            __builtin_amdgcn_fence(__ATOMIC_ACQUIRE, "agent");
            asm volatile("s_waitcnt vmcnt(0)" ::: "memory");
        }
    }
    __syncthreads();
}

enum { PH_PRO = 0, PH_INPROJ = 1, PH_MASK = 2, PH_ATT = 3, PH_UP = 4, PH_OUT = 5, PH_ROUTER = 6, PH_GU = 7, PH_DOWN = 8, PH_COMB = 9, PH_N = 10 };

__global__ void __launch_bounds__(512, 2) mega(Args args) {
    extern __shared__ __attribute__((aligned(16))) unsigned char lds_raw[];
    LAS unsigned char* lds = (LAS unsigned char*)lds_raw;
    const int tid = threadIdx.x, lane = tid & 63, wave = __builtin_amdgcn_readfirstlane(tid >> 6);
    const int G = gridDim.x, bx = blockIdx.x;
    const int vcu = (G % 8 == 0) ? (bx % 8) * (G / 8) + bx / 8 : bx;
    unsigned char* ws = args.ws;
    Bufs B;
    B.HB = (bf16_t*)(ws + WS_HB); B.WIN = (bf16_t*)(ws + WS_WIN); B.WA = (bf16_t*)(ws + WS_WA); B.WC = (bf16_t*)(ws + WS_WC); B.WO = (bf16_t*)(ws + WS_WO);
    B.WGU = (bf16_t*)(ws + WS_WGU); B.WD = (bf16_t*)(ws + WS_WD); B.Q = (bf16_t*)(ws + WS_Q); B.K = (bf16_t*)(ws + WS_K); B.V = (bf16_t*)(ws + WS_V);
    B.IQ = (bf16_t*)(ws + WS_IQ); B.IK = (bf16_t*)(ws + WS_IK); B.U = (bf16_t*)(ws + WS_U); B.SGA = (bf16_t*)(ws + WS_SGA); B.SGP = (bf16_t*)(ws + WS_SGP);
    B.YC = (bf16_t*)(ws + WS_YC); B.YA = (bf16_t*)(ws + WS_YA); B.MX = (bf16_t*)(ws + WS_MX); B.ACT = (bf16_t*)(ws + WS_ACT); B.Y4 = (bf16_t*)(ws + WS_Y4);
    B.IW = (float*)(ws + WS_IW); B.GATE = (float*)(ws + WS_GATE); B.LIST = (int*)(ws + WS_LIST); B.CNT = (int*)(ws + WS_CTL);
    B.WRH = (bf16_t*)(ws + WS_WRH); B.WRL = (bf16_t*)(ws + WS_WRL); B.R2 = (float*)(ws + WS_R2);
    B.H8 = (fp8_t*)(ws + WS_HB); B.WGU8 = (fp8_t*)(ws + WS_WGU); B.WD8 = (fp8_t*)(ws + WS_WD); B.ACT8 = (fp8_t*)(ws + WS_ACT); B.LISTR = (float*)(ws + WS_LISTR); B.LISTG = (float*)(ws + WS_LISTG);
    const float* x = args.in[0]; const float* norm_mix = args.in[1]; const float* w_in = args.in[2]; const float* w_pool = args.in[3]; const float* pool_scale = args.in[4];
    const float* w_attn_up = args.in[5]; const float* w_pool_up = args.in[6]; const float* w_out = args.in[7];
    const float* norm_ffn = args.in[8]; const float* w_router = args.in[9]; const float* b_router = args.in[10];
    const float* w_gate_up = args.in[11]; const float* b_gate_up = args.in[12]; const float* w_down = args.in[13]; const float* b_down = args.in[14]; const float* norm_final = args.in[15];
    const int lo = args.ph_lo, hi = args.ph_hi;
    if (tid < 4) ((LAS unsigned*)(lds + LDS_XB))[tid] = 0u;
    __syncthreads();
    const XcdBarrier xbar = xcd_barrier_post((unsigned*)(ws + WS_CTL) + CW_BAR, (volatile LAS unsigned*)(lds + LDS_XB));
#define IN(k) (lo <= (k) && (k) < hi)
#define SEAM(k) do { if (IN(k) && IN((k) + 1)) { xcd_barrier(xbar); } } while (0)

    if (IN(PH_PRO)) {
        LAS float* scr = (LAS float*)(lds + wave * 16384);
        const int gw = vcu * 8 + wave, NGW = G * 8;
        constexpr int I_IN = (D / 64) * (INP / 32), I_A = (AW / 64) * (D / 32), I_O = (D / 64) * (D / 32), I_GU = (D / 64) * (F2 / 32), I_D = (D / 64) * (D / 32);
        constexpr int NITEMS = I_IN + I_A + I_O + NE * I_GU + NE * I_D;
        for (int it = gw; it < NITEMS; it += NGW) {
            int r = it;
            if (r < I_IN) { transpose_item<1>(w_in, D, INC, B.WIN, scr, r, INP / 32, lane); continue; } r -= I_IN;
            if (r < I_A) { transpose_item<0>(w_attn_up, AW, D, B.WA, scr, r, D / 32, lane); continue; } r -= I_A;
            if (r < I_O) { transpose_item<0>(w_out, D, D, B.WO, scr, r, D / 32, lane); continue; } r -= I_O;
            if (r < NE * I_GU) { const int e = r / I_GU; transpose_item_f8<2>(w_gate_up + (size_t)e * D * F2, D, F2, B.WGU8 + (size_t)e * F2 * D, scr, r % I_GU, F2 / 32, lane); continue; } r -= NE * I_GU;
            { const int e = r / I_D; transpose_item_f8<0>(w_down + (size_t)e * D * D, D, D, B.WD8 + (size_t)e * D * D, scr, r % I_D, D / 32, lane); }
        }
        for (int idx = (vcu * 512 + tid); idx < D * PW; idx += G * 512) {
            const int n = idx & (D - 1), k = idx >> 10, g = k >> 7;
            const float* wp = w_pool + (size_t)k * 128; const float* ps = pool_scale + g * 128; const float* wu = w_pool_up + (size_t)(g * 128) * D + n;
            float a = 0.f;
            for (int d = 0; d < 128; ++d) a = fmaf(wp[d] * ps[d], wu[(size_t)d * D], a);
            B.WC[(size_t)n * PW + k] = (bf16_t)f2bf(a);
        }
        for (int idx = vcu * 512 + tid; idx < NE * D; idx += G * 512) { const int e = idx >> 10, k = idx & (D - 1); const float w = w_router[(size_t)k * NE + e]; const unsigned hh = f2bf(w); B.WRH[idx] = (bf16_t)hh; B.WRL[idx] = (bf16_t)f2bf(w - bf2f(hh)); }
        for (int m = gw; m < T; m += NGW) {
            const f32x4* xr = (const f32x4*)(x + (size_t)m * D) + lane;
            f32x4 v[4]; float s = 0.f;
#pragma unroll
            for (int j = 0; j < 4; ++j) { v[j] = xr[64 * j]; s += v[j].x * v[j].x + v[j].y * v[j].y + v[j].z * v[j].z + v[j].w * v[j].w; }
            const float r = rsqrtf(wave_sum(s) * (1.0f / D) + EPS);
            u32x2* o8 = (u32x2*)(B.HB + (size_t)m * D) + lane;
#pragma unroll
            for (int j = 0; j < 4; ++j) { const f32x4 g = ((const f32x4*)norm_mix)[lane + 64 * j]; u32x2 o; o.x = pk2(v[j].x * r * g.x, v[j].y * r * g.y); o.y = pk2(v[j].z * r * g.z, v[j].w * r * g.w); o8[64 * j] = o; }
        }
    }
    SEAM(PH_PRO);
    if (IN(PH_INPROJ)) {
        pg::StaticOrder So; So.init(T, INP, G, bx, B.HB, D, B.WIN, D);
        EpiInProj E{B};
        pg::gemm_phase<EpiInProj, pg::StaticOrder, false>(lds, D, D, D, So, E);
    }
    SEAM(PH_INPROJ);
    unsigned* MASK = (unsigned*)(ws + WS_MASK);
    if (IN(PH_MASK)) {
        pool_phase(lds, B, G, vcu);
        dsa_mask_phase(lds, B, MASK, G, vcu);
    }
    SEAM(PH_MASK);
    if (IN(PH_ATT)) att::attn_phase(lds, B, MASK, G, vcu, B.YC);
    SEAM(PH_ATT);
    if (IN(PH_UP)) {
        { pg::StaticOrder So; So.init(T, D, G, bx, B.YC, D, B.WA, AW); EpiAttnUp E{B}; pg::gemm_phase<EpiAttnUp, pg::StaticOrder, false>(lds, AW, D, AW, So, E); }
        asm volatile("s_waitcnt vmcnt(0)" ::: "memory"); __syncthreads();
        { pg::StaticOrder So; So.init(T, D, G, bx, B.YC + AW, D, B.WC, PW); EpiPoolUp E{B}; pg::gemm_phase<EpiPoolUp, pg::StaticOrder, false>(lds, PW, D, PW, So, E); }
    }
    SEAM(PH_UP);
    if (IN(PH_OUT)) {
        pg::StaticOrder So; So.init(T, D, G, bx, B.MX, D, B.WO, D);
        EpiOut E{x, args.out};
        pg::gemm_phase<EpiOut, pg::StaticOrder, false>(lds, D, D, D, So, E);
    }
    SEAM(PH_OUT);
    if (IN(PH_ROUTER)) router_phase(lds, args.out, norm_ffn, b_router, B, G, vcu);
    SEAM(PH_ROUTER);
    if (IN(PH_GU)) {
        LAS int* tab = (LAS int*)(lds + LDS_TAB);
        moe_tables(tab, B.CNT, 8);
        MoeOrder Mo; Mo.tab = tab; Mo.NT = 8; Mo.G = G; Mo.c = vcu; Mo.total = tab[NE]; Mo.Abase = (const char*)B.H8; Mo.Bbase = (const char*)B.WGU8; Mo.bexp = (size_t)F2 * D; Mo.list = B.LIST; Mo.dense_a = false;
        Mo.total = __builtin_amdgcn_readfirstlane(Mo.total);
        EpiGateUp E{B.ACT8, b_gate_up, B.LISTR};
        pg::gemm_phase<EpiGateUp, MoeOrder, true, true>(lds, D / 2, D / 2, D / 2, Mo, E);
        __syncthreads();
    }
    SEAM(PH_GU);
    if (IN(PH_DOWN)) {
        LAS int* tab = (LAS int*)(lds + LDS_TAB);
        moe_tables(tab, B.CNT, 4);
        MoeOrder Mo; Mo.tab = tab; Mo.NT = 4; Mo.G = G; Mo.c = vcu; Mo.total = tab[NE]; Mo.Abase = (const char*)B.ACT8; Mo.Bbase = (const char*)B.WD8; Mo.bexp = (size_t)D * D; Mo.list = B.LIST; Mo.dense_a = true;
        Mo.total = __builtin_amdgcn_readfirstlane(Mo.total);
        EpiDown E{(fp8_t*)B.Y4, b_down, B.LISTG, B.LIST};
        pg::gemm_phase<EpiDown, MoeOrder, false, true>(lds, D / 2, D / 2, D / 2, Mo, E);
    }
    SEAM(PH_DOWN);
    if (IN(PH_COMB)) combine_phase(args.out, norm_final, B, G, vcu);
#undef IN
#undef SEAM
}

extern "C" void kernel_launch(void* const* d_in, const int* in_sizes, int n_in, void* d_out, int out_size, void* d_ws, size_t ws_size, hipStream_t stream) {
    static int grid = 0;
    if (grid == 0) {
        if (ws_size < WS_END) { fprintf(stderr, "kernel_launch: workspace too small (%zu < %zu)\n", ws_size, (size_t)WS_END); grid = -1; return; }
        int dev = 0, cus = 0, per_cu = 0;
        (void)hipGetDevice(&dev); (void)hipDeviceGetAttribute(&cus, hipDeviceAttributeMultiprocessorCount, dev);
        (void)hipFuncSetAttribute((const void*)mega, hipFuncAttributeMaxDynamicSharedMemorySize, LDS_BYTES);
        (void)hipOccupancyMaxActiveBlocksPerMultiprocessor(&per_cu, (const void*)mega, 512, LDS_BYTES);
        if (per_cu < 1) { fprintf(stderr, "kernel_launch: occupancy query says %d blocks/CU\n", per_cu); grid = -1; return; }
        grid = cus;
    }
    if (grid < 0) return;
    unsigned char* ws = (unsigned char*)d_ws;
    (void)hipMemsetAsync(ws + WS_CTL, 0, 32768, stream);
    Args a{};
    for (int i = 0; i < 16; ++i) a.in[i] = (const float*)d_in[i];
    a.out = (float*)d_out; a.ws = ws; a.ph_lo = 0; a.ph_hi = PH_N;
    void* kargs[] = {&a};
    hipError_t e = hipLaunchCooperativeKernel((const void*)mega, dim3(grid), dim3(512), kargs, LDS_BYTES, stream);
    if (e != hipSuccess) fprintf(stderr, "kernel_launch: cooperative launch failed: %s (grid %d)\n", hipGetErrorString(e), grid);
}
```

```cpp
#include <hip/hip_runtime.h>
#include <cstdio>
#include <cstdint>

#define LAS __attribute__((address_space(3)))
typedef unsigned short bf16_t;
typedef short bf16x8 __attribute__((ext_vector_type(8)));
typedef float f32x4 __attribute__((ext_vector_type(4)));
typedef float f32x2 __attribute__((ext_vector_type(2)));
typedef unsigned u32x4 __attribute__((ext_vector_type(4)));
typedef unsigned u32x2 __attribute__((ext_vector_type(2)));
typedef int i32x4 __attribute__((ext_vector_type(4)));
typedef int i32x8 __attribute__((ext_vector_type(8)));
typedef unsigned char fp8_t;

constexpr int D = 1024, NB = 16, S = 2048, T = NB * S;
constexpr int NH = 8, HD = 64, AW = 512, NIH = 8, IDD = 32, NKEYS = 256;
constexpr int PW = 512, INC = 3496, INP = 3584;
constexpr int NE = 32, TOPK = 4, F2 = 2048;
constexpr float EPS = 1e-5f;
constexpr int C_Q = 0, C_K = 512, C_V = 576, C_IQ = 640, C_IK = 896, C_IW = 928, C_U = 936, C_GA = 1448, C_GP = 2472;

constexpr size_t MiB = 1u << 20;
constexpr size_t WS_CTL = 0;
constexpr size_t WS_LIST = 1 * MiB;
constexpr size_t WS_GATE = 5 * MiB;
constexpr size_t WS_HB = 8 * MiB;
constexpr size_t WS_WIN = 72 * MiB;
constexpr size_t WS_WA = 79 * MiB;
constexpr size_t WS_WC = 80 * MiB;
constexpr size_t WS_WO = 81 * MiB;
constexpr size_t WS_WGU = 84 * MiB;
constexpr size_t WS_WD = 212 * MiB;
constexpr size_t WS_Q = 276 * MiB;
constexpr size_t WS_K = 308 * MiB;
constexpr size_t WS_V = 312 * MiB;
constexpr size_t WS_IQ = 316 * MiB;
constexpr size_t WS_IK = 332 * MiB;
constexpr size_t WS_IW = 334 * MiB;
constexpr size_t WS_U = 336 * MiB;
constexpr size_t WS_SGA = 368 * MiB;
constexpr size_t WS_SGP = 432 * MiB;
constexpr size_t WS_YC = 496 * MiB;
constexpr size_t WS_YA = 560 * MiB;
constexpr size_t WS_MX = 624 * MiB;
constexpr size_t WS_ACT = 276 * MiB;
constexpr size_t WS_Y4 = 688 * MiB;
constexpr size_t WS_WRH = 6 * MiB;
constexpr size_t WS_WRL = 6 * MiB + 65536;
constexpr size_t WS_R2 = 7 * MiB;
constexpr size_t WS_LISTR = 952 * MiB;
constexpr size_t WS_LISTG = 956 * MiB;
constexpr size_t WS_MASK = 944 * MiB;
constexpr size_t WS_END = 960 * MiB;

__device__ __forceinline__ float bf2f(unsigned b) { return __uint_as_float(b << 16); }
__device__ __forceinline__ unsigned f2bf(float f) { unsigned u = __float_as_uint(f); return (u + 0x7fffu + ((u >> 16) & 1u)) >> 16; }
__device__ __forceinline__ unsigned pk2(float lo, float hi) { return f2bf(lo) | (f2bf(hi) << 16); }
__device__ __forceinline__ unsigned cvt_pk_bf16(float lo, float hi) { unsigned r; asm volatile("v_cvt_pk_bf16_f32 %0, %1, %2" : "=v"(r) : "v"(lo), "v"(hi)); return r; }
__device__ __forceinline__ unsigned pk4_fp8(float a, float b, float c, float d) { int w = __builtin_amdgcn_cvt_pk_fp8_f32(a, b, 0, false); w = __builtin_amdgcn_cvt_pk_fp8_f32(c, d, w, true); return (unsigned)w; }
__device__ __forceinline__ float wave_sum(float v) {
#pragma unroll
    for (int o = 32; o >= 1; o >>= 1) v += __shfl_xor(v, o);
    return v;
}
__device__ __forceinline__ float wave_max(float v) {
#pragma unroll
    for (int o = 32; o >= 1; o >>= 1) v = fmaxf(v, __shfl_xor(v, o));
    return v;
}
__device__ __forceinline__ float sigmoidf_(float x) { return __builtin_amdgcn_rcpf(1.0f + __builtin_amdgcn_exp2f(-1.4426950408889634f * x)); }

namespace pg {
constexpr int BM = 256, BK = 64, HALF = 128, HTB = HALF * BK * 2, STAGE_BYTES = 8 * HTB, NXCD = 8, WGM = 4;
__host__ __device__ __forceinline__ int lds_byte(int r, int c) { const int st = (r >> 4) * 2 + (c >> 5), rr = r & 15, cc = c & 31, ob = rr * 64 + cc * 2; return st * 1024 + (ob ^ (((ob >> 9) & 1) << 5)); }
__host__ __device__ __forceinline__ void stage_rc(int b, int& R, int& C) { const int st = b / 1024, sb = b % 1024, swz = sb ^ (((sb >> 9) & 1) << 5); R = (st >> 1) * 16 + swz / 64; C = (st & 1) * 32 + (swz % 64) / 2; }
__host__ __device__ __forceinline__ int perm32(int rho) { const int n = rho >> 4, i = rho & 15; return 8 * (i >> 2) + 4 * n + (i & 3); }

struct Unit { const char* a; const char* b; const int* rl; int nrows; int pm, pn, e; int lpos; };

struct StaticOrder {
    int nM, nN, nwg, G, c; const char* A; const char* Bt; size_t ta, tb;
    __device__ void init(int M, int N, int G_, int c_, const void* A_, int lda, const void* Bt_, int ldb) { nM = M / BM; nN = N / BM; nwg = nM * nN; G = G_; c = c_; A = (const char*)A_; Bt = (const char*)Bt_; ta = (size_t)BM * lda * 2; tb = (size_t)BM * ldb * 2; }
    __device__ bool next(int i, Unit& u) const {
        const long L = (long)i * G + c; if (L >= nwg) return false;
        int wgid = (int)L; { const int q = nwg / NXCD, r = nwg % NXCD, xcd = wgid % NXCD, off = wgid / NXCD; wgid = (xcd < r ? xcd * (q + 1) : r * (q + 1) + (xcd - r) * q) + off; }
        const int nig = WGM * nN, gid = wgid / nig, fm = gid * WGM, gsz = (nM - fm) < WGM ? (nM - fm) : WGM;
        u.pm = fm + ((wgid % nig) % gsz); u.pn = (wgid % nig) / gsz; u.e = 0; u.nrows = BM; u.rl = nullptr; u.lpos = 0;
        u.a = A + (size_t)u.pm * ta; u.b = Bt + (size_t)u.pn * tb; return true;
    }
};

template <class Epi, class Sched, bool GATHER, bool F8 = false>
__device__ __forceinline__ void gemm_phase(LAS unsigned char* lds, const int K, const int lda, const int ldb, const Sched& S, const Epi& E) {
    const int tid = threadIdx.x, wid = __builtin_amdgcn_readfirstlane(tid >> 6), lane = tid & 63, wr = wid >> 2, wc = wid & 3, fr = lane & 15, fq = lane >> 4;
    const int nt = K / BK;
    unsigned voffB[2], c0[2], c1[2], n0[2], n1[2];
    int Rs[2], Cs[2];
#pragma unroll
    for (int i = 0; i < 2; ++i) { int R, C; stage_rc(tid * 16 + i * 8192, R, C); Rs[i] = R; Cs[i] = C; const int Rb = Epi::PERM ? ((R & ~31) + perm32(R & 31)) : R;
        voffB[i] = (unsigned)(Rb * ldb + C) * 2u; c0[i] = (unsigned)(R * lda + C) * 2u; c1[i] = (unsigned)((R + HALF) * lda + C) * 2u; n0[i] = c0[i]; n1[i] = c1[i]; }
    const size_t kstep = (size_t)(BK * 2);
    const size_t hstepB = (size_t)HALF * ldb * 2;
    const unsigned ldsw = (unsigned)wid * 1024u;
    const int aoff = lds_byte(wr * 64 + fr, fq * 8), boff = lds_byte(wc * 32 + fr, fq * 8);
#define PG_GOFF(u, o0, o1) do { _Pragma("unroll") for (int _i = 0; _i < 2; ++_i) { const int _r0 = Rs[_i], _r1 = Rs[_i] + HALF; \
        const int _t0 = (u).rl[_r0 < (u).nrows ? _r0 : 0] >> 2, _t1 = (u).rl[_r1 < (u).nrows ? _r1 : 0] >> 2; \
        o0[_i] = (unsigned)(_t0 * lda + Cs[_i]) * 2u; o1[_i] = (unsigned)(_t1 * lda + Cs[_i]) * 2u; } } while (0)
#define PG_SA(b, h) (((b) * 2 + (h)) * HTB)
#define PG_SB(b, h) ((4 + (b) * 2 + (h)) * HTB)
#define PG_STAGE(bufoff, gbase, voff) do { _Pragma("unroll") for (int _i = 0; _i < 2; ++_i) \
        __builtin_amdgcn_global_load_lds((const unsigned*)((const char*)(gbase) + (voff)[_i]), (LAS unsigned*)(lds + (bufoff) + ldsw + _i * 8192), 16, 0, 0); } while (0)
#define PG_LDA(dst, b, h) do { _Pragma("unroll") for (int m = 0; m < 4; ++m) _Pragma("unroll") for (int k = 0; k < 2; ++k) dst[m][k] = *(const LAS bf16x8*)(lds + PG_SA(b, h) + aoff + m * 2048 + k * 1024); } while (0)
#define PG_LDB(dst, b, h) do { _Pragma("unroll") for (int n = 0; n < 2; ++n) _Pragma("unroll") for (int k = 0; k < 2; ++k) dst[n][k] = *(const LAS bf16x8*)(lds + PG_SB(b, h) + boff + n * 2048 + k * 1024); } while (0)
#define PG_CAT(x0, x1) __builtin_shufflevector(__builtin_bit_cast(i32x4, x0), __builtin_bit_cast(i32x4, x1), 0, 1, 2, 3, 4, 5, 6, 7)
#define PG_MMA(ai, bj, At, Bt) do { __builtin_amdgcn_s_setprio(1); \
        if constexpr (F8) { _Pragma("unroll") for (int m = 0; m < 4; ++m) _Pragma("unroll") for (int n = 0; n < 2; ++n) \
            asm volatile("v_mfma_scale_f32_16x16x128_f8f6f4 %0, %1, %2, %0, %3, %4 op_sel_hi:[0,0,0]" : "+v"(acc[ai][bj][m][n]) : "v"(PG_CAT(Bt[n][0], Bt[n][1])), "v"(PG_CAT(At[m][0], At[m][1])), "v"(sclW), "v"(sclA)); } \
        else { _Pragma("unroll") for (int m = 0; m < 4; ++m) _Pragma("unroll") for (int n = 0; n < 2; ++n) _Pragma("unroll") for (int k = 0; k < 2; ++k) \
            acc[ai][bj][m][n] = __builtin_amdgcn_mfma_f32_16x16x32_bf16(Bt[n][k], At[m][k], acc[ai][bj][m][n], 0, 0, 0); } \
        __builtin_amdgcn_s_setprio(0); } while (0)
#define PG_WAIT_V(n) asm volatile("s_waitcnt vmcnt(" #n ")" ::: "memory")
#define PG_WAIT_L(n) asm volatile("s_waitcnt lgkmcnt(" #n ")" ::: "memory")
#define PG_BAR __builtin_amdgcn_s_barrier()
#define PG_SCHED __builtin_amdgcn_sched_barrier(0)
    Unit cur, nxt; int ui = 0;
    if (!S.next(0, cur)) return;
    f32x4 acc[2][2][4][2];
#pragma unroll
    for (int a = 0; a < 2; ++a)
#pragma unroll
        for (int b = 0; b < 2; ++b)
#pragma unroll
            for (int m = 0; m < 4; ++m)
#pragma unroll
                for (int n = 0; n < 2; ++n) acc[a][b][m][n] = (f32x4){0.f, 0.f, 0.f, 0.f};
    bf16x8 At[4][2], B0[2][2], B1[2][2];
    int sclW = 0x79797979, sclA = 0x7f7f7f7f;
    asm volatile("" : "+v"(sclW), "+v"(sclA));
    const char* cA = cur.a; const char* cB = cur.b;
    if (GATHER) PG_GOFF(cur, c0, c1);
    PG_STAGE(PG_SB(0, 0), cB, voffB); PG_STAGE(PG_SA(0, 0), cA, c0); PG_STAGE(PG_SB(0, 1), cB + hstepB, voffB); PG_STAGE(PG_SA(0, 1), cA, c1);
    if (wr == 1) PG_BAR;
    PG_WAIT_V(4); PG_BAR;
    PG_STAGE(PG_SB(1, 0), cB + kstep, voffB); PG_STAGE(PG_SA(1, 0), cA + kstep, c0); PG_STAGE(PG_SB(1, 1), cB + hstepB + kstep, voffB);
    PG_WAIT_V(6); PG_BAR;
    for (;;) {
        const bool has_next = S.next(ui + 1, nxt);
        const char* nA = has_next ? nxt.a : cA; const char* nB = has_next ? nxt.b : cB;
        if (GATHER) { if (has_next) PG_GOFF(nxt, n0, n1); else { n0[0] = c0[0]; n0[1] = c0[1]; n1[0] = c1[0]; n1[1] = c1[1]; } }
        for (int t = 0; t < nt; t += 2) {
            const bool last = (t == nt - 2);
            const char* a1 = cA + (size_t)(t + 1) * kstep;
            const char* a2 = last ? nA : cA + (size_t)(t + 2) * kstep; const char* b2 = last ? nB : cB + (size_t)(t + 2) * kstep;
            const char* a3 = a2 + kstep; const char* b3 = b2 + kstep;
            unsigned s0[2], s1[2];
            s0[0] = last ? n0[0] : c0[0]; s0[1] = last ? n0[1] : c0[1]; s1[0] = last ? n1[0] : c1[0]; s1[1] = last ? n1[1] : c1[1];
            PG_LDB(B0, 0, 0); PG_SCHED; PG_LDA(At, 0, 0); PG_STAGE(PG_SA(1, 1), a1, c1);
            PG_WAIT_L(8); PG_BAR; PG_WAIT_L(0); PG_MMA(0, 0, At, B0); PG_BAR; PG_SCHED;
            PG_LDB(B1, 0, 1); PG_STAGE(PG_SB(0, 0), b2, voffB);
            PG_BAR; PG_WAIT_L(0); PG_MMA(0, 1, At, B1); PG_BAR;
            PG_LDA(At, 0, 1); PG_STAGE(PG_SA(0, 0), a2, s0);
            PG_BAR; PG_WAIT_L(0); PG_MMA(1, 0, At, B0); PG_BAR; PG_SCHED;
            PG_STAGE(PG_SB(0, 1), b2 + hstepB, voffB);
            PG_WAIT_V(6); PG_BAR; PG_MMA(1, 1, At, B1); PG_BAR;
            PG_LDB(B0, 1, 0); PG_SCHED; PG_LDA(At, 1, 0); PG_STAGE(PG_SA(0, 1), a2, s1);
            PG_WAIT_L(8); PG_BAR; PG_WAIT_L(0); PG_MMA(0, 0, At, B0); PG_BAR; PG_SCHED;
            PG_LDB(B1, 1, 1); PG_STAGE(PG_SB(1, 0), b3, voffB);
            PG_BAR; PG_WAIT_L(0); PG_MMA(0, 1, At, B1); PG_BAR;
            PG_LDA(At, 1, 1); PG_STAGE(PG_SA(1, 0), a3, s0);
            PG_BAR; PG_WAIT_L(0); PG_MMA(1, 0, At, B0); PG_BAR; PG_SCHED;
            PG_STAGE(PG_SB(1, 1), b3 + hstepB, voffB);
            PG_WAIT_V(6); PG_BAR; PG_MMA(1, 1, At, B1); PG_BAR;
        }
        if constexpr (F8) asm volatile("s_nop 15\n\ts_nop 15" ::: "memory");
        E(acc, cur, wr, wc, fr, fq);
        if (!has_next) break;
#pragma unroll
        for (int a = 0; a < 2; ++a)
#pragma unroll
            for (int b = 0; b < 2; ++b)
#pragma unroll
                for (int m = 0; m < 4; ++m)
#pragma unroll
                    for (int n = 0; n < 2; ++n) acc[a][b][m][n] = (f32x4){0.f, 0.f, 0.f, 0.f};
        cur = nxt; cA = nA; cB = nB; ++ui;
        if (GATHER) { c0[0] = n0[0]; c0[1] = n0[1]; c1[0] = n1[0]; c1[1] = n1[1]; }
    }
    PG_WAIT_V(0);
    if (wr == 0) PG_BAR;
    PG_BAR;
#undef PG_GOFF
#undef PG_SA
#undef PG_SB
#undef PG_STAGE
#undef PG_LDA
#undef PG_LDB
#undef PG_MMA
#undef PG_CAT
#undef PG_WAIT_V
#undef PG_WAIT_L
#undef PG_BAR
#undef PG_SCHED
}
}

struct Bufs {
    bf16_t *HB, *WIN, *WA, *WC, *WO, *WGU, *WD, *Q, *K, *V, *IQ, *IK, *U, *SGA, *SGP, *YC, *YA, *MX, *ACT, *Y4;
    float *IW, *GATE; int* LIST; int* CNT; bf16_t *WRH, *WRL; float* R2;
    fp8_t *H8, *WGU8, *WD8, *ACT8; float *LISTR, *LISTG;
};
__device__ __forceinline__ u32x4 pack8(const f32x4& v0, const f32x4& v1) { u32x4 w; w.x = cvt_pk_bf16(v0[0], v0[1]); w.y = cvt_pk_bf16(v0[2], v0[3]); w.z = cvt_pk_bf16(v1[0], v1[1]); w.w = cvt_pk_bf16(v1[2], v1[3]); return w; }
__device__ __forceinline__ void unpack8(const u32x4& w, f32x4& v0, f32x4& v1) {
    v0[0] = bf2f(w.x & 0xffffu); v0[1] = bf2f(w.x >> 16); v0[2] = bf2f(w.y & 0xffffu); v0[3] = bf2f(w.y >> 16);
    v1[0] = bf2f(w.z & 0xffffu); v1[1] = bf2f(w.z >> 16); v1[2] = bf2f(w.w & 0xffffu); v1[3] = bf2f(w.w >> 16); }

struct EpiInProj {
    static constexpr bool PERM = true;
    Bufs B;
    __device__ __forceinline__ void operator()(const f32x4 (&acc)[2][2][4][2], const pg::Unit& u, int wr, int wc, int fr, int fq) const {
        asm volatile("" : "+v"(fr), "+v"(fq));
        const int pn = u.pn;
        bf16_t* base; int pitch, coff; bool sig = false;
        if (pn < 2) { base = B.Q; pitch = 512; coff = pn * 256; }
        else if (pn == 3) { base = B.IQ; pitch = 256; coff = 0; }
        else if (pn < 6) { base = B.U; pitch = 512; coff = (pn - 4) * 256; }
        else if (pn < 10) { base = B.SGA; pitch = 1024; coff = (pn - 6) * 256; sig = true; }
        else { base = B.SGP; pitch = 1024; coff = (pn - 10) * 256; sig = true; }
#pragma unroll
        for (int ai = 0; ai < 2; ++ai)
#pragma unroll
            for (int m = 0; m < 4; ++m) {
                const size_t row = (size_t)u.pm * 256 + ai * 128 + wr * 64 + m * 16 + fr;
#pragma unroll
                for (int bj = 0; bj < 2; ++bj) {
                    const int cc = bj * 128 + wc * 32 + fq * 8;
                    f32x4 v0 = acc[ai][bj][m][0], v1 = acc[ai][bj][m][1];
                    if (pn == 2) {
                        if (cc < 64) *(u32x4*)(B.K + row * 64 + cc) = pack8(v0, v1);
                        else if (cc < 128) *(u32x4*)(B.V + row * 64 + (cc - 64)) = pack8(v0, v1);
                        else if (cc < 160) *(u32x4*)(B.IK + row * 32 + (cc - 128)) = pack8(v0, v1);
                        else if (cc == 160) { *(f32x4*)(B.IW + row * 8) = v0 * 0.0625f; *(f32x4*)(B.IW + row * 8 + 4) = v1 * 0.0625f; }
                    } else {
                        if (sig) {
#pragma unroll
                            for (int j = 0; j < 4; ++j) { v0[j] = sigmoidf_(v0[j]); v1[j] = sigmoidf_(v1[j]); }
                        }
                        *(u32x4*)(base + row * pitch + coff + cc) = pack8(v0, v1);
                    }
                }
            }
    }
};
#define EPI_PIN4(v) asm volatile("" : "+v"(v))
struct EpiAttnUp {
    static constexpr bool PERM = true;
    Bufs B;
    __device__ __forceinline__ void operator()(const f32x4 (&acc)[2][2][4][2], const pg::Unit& u, int wr, int wc, int fr, int fq) const {
        asm volatile("" : "+v"(fr), "+v"(fq));
        const size_t o0 = ((size_t)u.pm * 256 + wr * 64 + fr) * 1024 + u.pn * 256 + wc * 32 + fq * 8;
        u32x4 g[2][4][2];
#pragma unroll
        for (int ai = 0; ai < 2; ++ai)
#pragma unroll
            for (int m = 0; m < 4; ++m)
#pragma unroll
                for (int bj = 0; bj < 2; ++bj) g[ai][m][bj] = *(const u32x4*)(B.SGA + o0 + (size_t)(ai * 128 + m * 16) * 1024 + bj * 128);
        asm volatile("s_waitcnt vmcnt(0)" ::: "memory");
#pragma unroll
        for (int ai = 0; ai < 2; ++ai)
#pragma unroll
            for (int m = 0; m < 4; ++m)
#pragma unroll
                for (int bj = 0; bj < 2; ++bj) EPI_PIN4(g[ai][m][bj]);
#pragma unroll
        for (int ai = 0; ai < 2; ++ai)
#pragma unroll
            for (int m = 0; m < 4; ++m)
#pragma unroll
                for (int bj = 0; bj < 2; ++bj) {
                    f32x4 g0, g1; unpack8(g[ai][m][bj], g0, g1);
                    *(u32x4*)(B.YA + o0 + (size_t)(ai * 128 + m * 16) * 1024 + bj * 128) = pack8(acc[ai][bj][m][0] * g0, acc[ai][bj][m][1] * g1);
                }
    }
};
struct EpiPoolUp {
    static constexpr bool PERM = true;
    Bufs B;
    __device__ __forceinline__ void operator()(const f32x4 (&acc)[2][2][4][2], const pg::Unit& u, int wr, int wc, int fr, int fq) const {
        asm volatile("" : "+v"(fr), "+v"(fq));
        const size_t o0 = ((size_t)u.pm * 256 + wr * 64 + fr) * 1024 + u.pn * 256 + wc * 32 + fq * 8;
#pragma unroll
        for (int ai = 0; ai < 2; ++ai) {
            u32x4 g[4][2], y[4][2];
#pragma unroll
            for (int m = 0; m < 4; ++m)
#pragma unroll
                for (int bj = 0; bj < 2; ++bj) { const size_t o = o0 + (size_t)(ai * 128 + m * 16) * 1024 + bj * 128; g[m][bj] = *(const u32x4*)(B.SGP + o); y[m][bj] = *(const u32x4*)(B.YA + o); }
            asm volatile("s_waitcnt vmcnt(0)" ::: "memory");
#pragma unroll
            for (int m = 0; m < 4; ++m)
#pragma unroll
                for (int bj = 0; bj < 2; ++bj) { EPI_PIN4(g[m][bj]); EPI_PIN4(y[m][bj]); }
#pragma unroll
            for (int m = 0; m < 4; ++m)
#pragma unroll
                for (int bj = 0; bj < 2; ++bj) {
                    f32x4 g0, g1, y0, y1; unpack8(g[m][bj], g0, g1); unpack8(y[m][bj], y0, y1);
                    *(u32x4*)(B.MX + o0 + (size_t)(ai * 128 + m * 16) * 1024 + bj * 128) = pack8(y0 + acc[ai][bj][m][0] * g0, y1 + acc[ai][bj][m][1] * g1);
                }
        }
    }
};
struct EpiOut {
    static constexpr bool PERM = false;
    const float* x; float* x2;
    __device__ __forceinline__ void operator()(const f32x4 (&acc)[2][2][4][2], const pg::Unit& u, int wr, int wc, int fr, int fq) const {
        asm volatile("" : "+v"(fr), "+v"(fq));
        const size_t o0 = ((size_t)u.pm * 256 + wr * 64 + fr) * 1024 + u.pn * 256 + wc * 32 + fq * 4;
#pragma unroll
        for (int ai = 0; ai < 2; ++ai) {
            f32x4 xv[4][2][2];
#pragma unroll
            for (int m = 0; m < 4; ++m)
#pragma unroll
                for (int bj = 0; bj < 2; ++bj)
#pragma unroll
                    for (int n = 0; n < 2; ++n) xv[m][bj][n] = *(const f32x4*)(x + o0 + (size_t)(ai * 128 + m * 16) * 1024 + bj * 128 + n * 16);
            asm volatile("s_waitcnt vmcnt(0)" ::: "memory");
#pragma unroll
            for (int m = 0; m < 4; ++m)
#pragma unroll
                for (int bj = 0; bj < 2; ++bj)
#pragma unroll
                    for (int n = 0; n < 2; ++n) EPI_PIN4(xv[m][bj][n]);
#pragma unroll
            for (int m = 0; m < 4; ++m)
#pragma unroll
                for (int bj = 0; bj < 2; ++bj)
#pragma unroll
                    for (int n = 0; n < 2; ++n) *(f32x4*)(x2 + o0 + (size_t)(ai * 128 + m * 16) * 1024 + bj * 128 + n * 16) = xv[m][bj][n] + acc[ai][bj][m][n];
        }
    }
};
struct EpiGateUp {
    static constexpr bool PERM = true;
    fp8_t* ACT; const float* bias; const float* LR;
    __device__ __forceinline__ void operator()(const f32x4 (&acc)[2][2][4][2], const pg::Unit& u, int wr, int wc, int fr, int fq) const {
        asm volatile("" : "+v"(fr), "+v"(fq));
        const int ac0 = u.pn * 128 + wc * 32 + fq * 8;
        const float* bp = bias + (size_t)u.e * F2 + 2 * ac0;
        f32x4 bq[4];
#pragma unroll
        for (int j = 0; j < 4; ++j) bq[j] = *(const f32x4*)(bp + 4 * j);
        float rs8[8];
#pragma unroll
        for (int i = 0; i < 8; ++i) { const int rt = (i >> 2) * 128 + wr * 64 + (i & 3) * 16 + fr; rs8[i] = LR[u.lpos + (rt < u.nrows ? rt : 0)]; }
        asm volatile("s_waitcnt vmcnt(0)" ::: "memory");
#pragma unroll
        for (int i = 0; i < 8; ++i) asm volatile("" : "+v"(rs8[i]));
#pragma unroll
        for (int j = 0; j < 4; ++j) asm volatile("" : "+v"(bq[j]));
#pragma unroll
        for (int ai = 0; ai < 2; ++ai)
#pragma unroll
            for (int m = 0; m < 4; ++m) {
                const int rt = ai * 128 + wr * 64 + m * 16 + fr;
                if (rt < u.nrows) {
                    const float rs = rs8[ai * 4 + m];
                    f32x4 o[2];
#pragma unroll
                    for (int n = 0; n < 2; ++n)
#pragma unroll
                        for (int jp = 0; jp < 2; ++jp) {
                            const int c = 4 * n + 2 * jp;
                            const f32x2 ag = {acc[ai][0][m][n][2 * jp], acc[ai][0][m][n][2 * jp + 1]}, au = {acc[ai][1][m][n][2 * jp], acc[ai][1][m][n][2 * jp + 1]};
                            const f32x2 bg = {bq[c >> 1][(c & 1) * 2], bq[(c + 1) >> 1][((c + 1) & 1) * 2]}, bu = {bq[c >> 1][(c & 1) * 2 + 1], bq[(c + 1) >> 1][((c + 1) & 1) * 2 + 1]};
                            f32x2 g = ag * rs + bg, uu = au * rs + bu;
                            g.x = fminf(g.x, 7.0f); g.y = fminf(g.y, 7.0f);
                            uu.x = __builtin_amdgcn_fmed3f(uu.x, -7.0f, 7.0f); uu.y = __builtin_amdgcn_fmed3f(uu.y, -7.0f, 7.0f);
                            const f32x2 t = g * (-1.702f * 1.4426950408889634f);
                            f32x2 e; e.x = __builtin_amdgcn_exp2f(t.x); e.y = __builtin_amdgcn_exp2f(t.y);
                            const f32x2 d = e + 1.0f;
                            f32x2 sg; sg.x = __builtin_amdgcn_rcpf(d.x); sg.y = __builtin_amdgcn_rcpf(d.y);
                            const f32x2 gs = g * sg, r2 = uu * gs + gs;
                            o[n][2 * jp] = r2.x; o[n][2 * jp + 1] = r2.y;
                        }
                    *(u32x2*)(ACT + ((size_t)u.pm * 256 + rt) * 1024 + ac0) = (u32x2){pk4_fp8(o[0][0], o[0][1], o[0][2], o[0][3]), pk4_fp8(o[1][0], o[1][1], o[1][2], o[1][3])};
                }
            }
    }
};
struct EpiDown {
    static constexpr bool PERM = true;
    fp8_t* Y4; const float* bias; const float* gates; const int* LI;
    __device__ __forceinline__ void operator()(const f32x4 (&acc)[2][2][4][2], const pg::Unit& u, int wr, int wc, int fr, int fq) const {
        asm volatile("" : "+v"(fr), "+v"(fq));
        f32x4 bq[2][2];
#pragma unroll
        for (int bj = 0; bj < 2; ++bj) { const float* bp = bias + (size_t)u.e * 1024 + u.pn * 256 + bj * 128 + wc * 32 + fq * 8; bq[bj][0] = *(const f32x4*)bp; bq[bj][1] = *(const f32x4*)(bp + 4); }
        int a8[8]; float g8[8];
#pragma unroll
        for (int i = 0; i < 8; ++i) { const int rt = (i >> 2) * 128 + wr * 64 + (i & 3) * 16 + fr; const int q = u.lpos + (rt < u.nrows ? rt : 0); a8[i] = LI[q]; g8[i] = gates[q]; }
        asm volatile("s_waitcnt vmcnt(0)" ::: "memory");
#pragma unroll
        for (int i = 0; i < 8; ++i) asm volatile("" : "+v"(a8[i]), "+v"(g8[i]));
#pragma unroll
        for (int bj = 0; bj < 2; ++bj) asm volatile("" : "+v"(bq[bj][0]), "+v"(bq[bj][1]));
#pragma unroll
        for (int ai = 0; ai < 2; ++ai)
#pragma unroll
            for (int m = 0; m < 4; ++m) {
                const int rt = ai * 128 + wr * 64 + m * 16 + fr;
                if (rt < u.nrows) {
                    const int a = a8[ai * 4 + m]; const float gt = g8[ai * 4 + m] * 8.0f;
#pragma unroll
                    for (int bj = 0; bj < 2; ++bj) {
                        const f32x4 y0 = (acc[ai][bj][m][0] + bq[bj][0]) * gt, y1 = (acc[ai][bj][m][1] + bq[bj][1]) * gt;
                        *(u32x2*)(Y4 + (size_t)a * 1024 + u.pn * 256 + bj * 128 + wc * 32 + fq * 8) = (u32x2){pk4_fp8(y0[0], y0[1], y0[2], y0[3]), pk4_fp8(y1[0], y1[1], y1[2], y1[3])};
                    }
                }
            }
    }
};

struct MoeOrder {
    const LAS int* tab; int NT, G, c, total; const char* Abase; const char* Bbase; size_t bexp; const int* list; bool dense_a;
    __device__ bool next(int i, pg::Unit& u) const {
        const long L = (long)i * G + c; if (L >= total) return false;
        int e = 0;
        for (int j = 1; j < NE; ++j) e += (tab[j] <= (int)L) ? 1 : 0;
        e = __builtin_amdgcn_readfirstlane(e);
        const int l = (int)L - __builtin_amdgcn_readfirstlane(tab[e]), rt = l / NT, pn = l - rt * NT;
        const int cnt = __builtin_amdgcn_readfirstlane(tab[64 + e]), ro = __builtin_amdgcn_readfirstlane(tab[128 + e]);
        u.e = e; u.pn = pn; u.pm = ro + rt; u.nrows = (cnt - rt * 256) < 256 ? (cnt - rt * 256) : 256;
        u.rl = list + (size_t)e * T + rt * 256; u.lpos = e * T + rt * 256;
        u.a = dense_a ? Abase + (size_t)(ro + rt) * 256 * 1024 : Abase;
        u.b = Bbase + (size_t)e * bexp + (size_t)pn * 256 * 1024;
        return true;
    }
};

__device__ __forceinline__ int inproj_src(int n) {
    if (n < 512) return C_Q + n;
    if (n < 576) return C_K + (n - 512);
    if (n < 640) return C_V + (n - 576);
    if (n < 672) return C_IK + (n - 640);
    if (n < 680) return C_IW + (n - 672);
    if (n < 768) return -1;
    if (n < 1024) return C_IQ + (n - 768);
    if (n < 1536) return C_U + (n - 1024);
    if (n < 2560) return C_GA + (n - 1536);
    return C_GP + (n - 2560);
}
template <int MODE> __device__ __forceinline__ void transpose_item(const float* W, int K, int N, bf16_t* WT, LAS float* scr, int item, int nblk, int lane) {
    const int kb = item / nblk, nb = item % nblk, k0 = 64 * kb, n0 = 32 * nb;
    const int nd = n0 + (lane & 31);
    int sc;
    if (MODE == 0) sc = nd; else if (MODE == 1) sc = inproj_src(nd); else { const int p = nd >> 8, bj = (nd >> 7) & 1, i = nd & 127; sc = 2 * (128 * p + i) + bj; }
#pragma unroll 8
    for (int i = 0; i < 32; ++i) { const int kk = 2 * i + (lane >> 5); scr[kk * 33 + (lane & 31)] = (sc >= 0) ? W[(size_t)(k0 + kk) * N + sc] : 0.f; }
    asm volatile("s_waitcnt lgkmcnt(0)" ::: "memory");
    const int c = lane & 7;
#pragma unroll
    for (int j = 0; j < 4; ++j) { const int n = (lane >> 3) + 8 * j; const LAS float* s = scr + (8 * c) * 33 + n;
        u32x4 o; o.x = pk2(s[0 * 33], s[1 * 33]); o.y = pk2(s[2 * 33], s[3 * 33]); o.z = pk2(s[4 * 33], s[5 * 33]); o.w = pk2(s[6 * 33], s[7 * 33]);
        *(u32x4*)(WT + (size_t)(n0 + n) * K + k0 + 8 * c) = o; }
    asm volatile("s_waitcnt lgkmcnt(0)" ::: "memory");
}

template <int MODE> __device__ __forceinline__ void transpose_item_f8(const float* W, int K, int N, fp8_t* WT, LAS float* scr, int item, int nblk, int lane) {
    const int kb = item / nblk, nb = item % nblk, k0 = 64 * kb, n0 = 32 * nb;
    const int nd = n0 + (lane & 31);
    int sc;
    if (MODE == 0) sc = nd; else { const int p = nd >> 8, bj = (nd >> 7) & 1, i = nd & 127; sc = 2 * (128 * p + i) + bj; }
    float v[32];
#pragma unroll
    for (int i = 0; i < 32; ++i) v[i] = W[(size_t)(k0 + 2 * i + (lane >> 5)) * N + sc];
#pragma unroll
    for (int i = 0; i < 32; ++i) scr[(2 * i + (lane >> 5)) * 33 + (lane & 31)] = v[i] * 64.0f;
    asm volatile("s_waitcnt lgkmcnt(0)" ::: "memory");
    const int c = lane & 3;
#pragma unroll
    for (int j = 0; j < 2; ++j) { const int n = (lane >> 2) + 16 * j; const LAS float* s = scr + (16 * c) * 33 + n;
        u32x4 o; o.x = pk4_fp8(s[0 * 33], s[1 * 33], s[2 * 33], s[3 * 33]); o.y = pk4_fp8(s[4 * 33], s[5 * 33], s[6 * 33], s[7 * 33]);
        o.z = pk4_fp8(s[8 * 33], s[9 * 33], s[10 * 33], s[11 * 33]); o.w = pk4_fp8(s[12 * 33], s[13 * 33], s[14 * 33], s[15 * 33]);
        *(u32x4*)(WT + (size_t)(n0 + n) * K + k0 + 16 * c) = o; }
    asm volatile("s_waitcnt lgkmcnt(0)" ::: "memory");
}

struct Args {
    const float* in[16]; float* out; unsigned char* ws; int ph_lo, ph_hi;
};

constexpr int LDS_XB = 151552 - 64;
constexpr int CW_BAR = 1024;
constexpr int LDS_TAB = pg::STAGE_BYTES;
constexpr int LDS_BYTES = 151552;

__device__ __forceinline__ void moe_tables(LAS int* tab, const int* cnt_g, int NT) {
    if (threadIdx.x < 64) {
        const int lane = threadIdx.x;
        const int c = lane < NE ? __hip_atomic_load(cnt_g + lane, __ATOMIC_RELAXED, __HIP_MEMORY_SCOPE_AGENT) : 0;
        const int rt = (c + 255) >> 8;
        int pre = rt;
#pragma unroll
        for (int o = 1; o < 64; o <<= 1) { const int v = __shfl_up(pre, o); if (lane >= o) pre += v; }
        const int excl = pre - rt;
        if (lane < NE) { tab[lane] = excl * NT; tab[64 + lane] = c; tab[128 + lane] = excl; }
        if (lane == NE) { tab[NE] = excl * NT; tab[128 + NE] = excl; }
    }
    __syncthreads();
}


typedef float f32x16 __attribute__((ext_vector_type(16)));
__device__ __forceinline__ int wave_total_le32(int c) {
    int tot = 0;
#pragma unroll
    for (int b = 0; b < 6; ++b) tot += __builtin_popcountll(__ballot((c >> b) & 1)) << b;
    return tot;
}
__device__ __forceinline__ unsigned ord_key(float f) { const unsigned u = __float_as_uint(f); return u ^ ((unsigned)((int)u >> 31) | 0x80000000u); }
template <int CTRL> __device__ __forceinline__ float dppf(float v) { return __int_as_float(__builtin_amdgcn_update_dpp(0, __float_as_int(v), CTRL, 0xf, 0xf, true)); }
__device__ __forceinline__ float wave_max_u(float v) {
    v = fmaxf(v, dppf<0xB1>(v)); v = fmaxf(v, dppf<0x4E>(v)); v = fmaxf(v, dppf<0x141>(v)); v = fmaxf(v, dppf<0x140>(v));
    const int b = __float_as_int(v);
    return fmaxf(fmaxf(__int_as_float(__builtin_amdgcn_readlane(b, 0)), __int_as_float(__builtin_amdgcn_readlane(b, 16))), fmaxf(__int_as_float(__builtin_amdgcn_readlane(b, 32)), __int_as_float(__builtin_amdgcn_readlane(b, 48))));
}
__device__ __forceinline__ int wave_incl_scan(int v) {
    v += __builtin_amdgcn_update_dpp(0, v, 0x111, 0xf, 0xf, false);
    v += __builtin_amdgcn_update_dpp(0, v, 0x112, 0xf, 0xf, false);
    v += __builtin_amdgcn_update_dpp(0, v, 0x114, 0xf, 0xf, false);
    v += __builtin_amdgcn_update_dpp(0, v, 0x118, 0xf, 0xf, false);
    v += __builtin_amdgcn_update_dpp(0, v, 0x142, 0xa, 0xf, false);
    v += __builtin_amdgcn_update_dpp(0, v, 0x143, 0xc, 0xf, false);
    return v;
}
__device__ __forceinline__ unsigned select_word(const float (&x)[32], unsigned vm, int lane, LAS int* hist, LAS float* cval, const LAS float* srow) {
    unsigned active = vm, sel = 0u; int need = NKEYS;
    for (;;) {
        float mnn = -__builtin_inff(), mxx = -__builtin_inff();
#pragma unroll
        for (int i = 0; i < 32; ++i) { const bool a = (active >> i) & 1u; mnn = a ? fmaxf(mnn, -x[i]) : mnn; mxx = a ? fmaxf(mxx, x[i]) : mxx; }
        const float mn = -wave_max_u(mnn), mx = wave_max_u(mxx);
        const float scale = 256.0f / (mx - mn);
        if (!(scale < 1.0e37f)) {
            if (mn == mx) {
                const int c = __builtin_popcount(active); const int incl = wave_incl_scan(c);
                int allow = need - (incl - c);
#pragma unroll
                for (int i = 0; i < 32; ++i) { const bool a = (active >> i) & 1u; if (a && allow > 0) sel |= 1u << i; if (a) --allow; }
                return sel;
            }
            const unsigned kmax = ord_key(mx); const unsigned span = kmax - ord_key(mn); const int nbits = 32 - __builtin_clz(span); const int shift = nbits > 6 ? nbits - 6 : 0;
            *(LAS f32x4*)(hist + 4 * lane) = (f32x4){0.f, 0.f, 0.f, 0.f};
#pragma unroll
            for (int i = 0; i < 32; ++i) { const int b = (int)((kmax - ord_key(x[i])) >> shift); __hip_atomic_fetch_add(&hist[((active >> i) & 1u) ? b : 255], (int)((active >> i) & 1u), __ATOMIC_RELAXED, __HIP_MEMORY_SCOPE_WAVEFRONT); }
            const int h = hist[lane];
            const int incl = wave_incl_scan(h);
            const int Ls = __builtin_ctzll(__ballot(incl >= need));
            const int above = __builtin_amdgcn_readlane(incl, Ls) - __builtin_amdgcn_readlane(h, Ls), cnt = __builtin_amdgcn_readlane(h, Ls);
            unsigned na = 0u;
#pragma unroll
            for (int i = 0; i < 32; ++i) { const int b = (int)((kmax - ord_key(x[i])) >> shift); const unsigned bit = active & (1u << i); sel |= (b < Ls) ? bit : 0u; na |= (b == Ls) ? bit : 0u; }
            active = na; need -= above;
            if (cnt <= 64) break;
            continue;
        }
        *(LAS f32x4*)(hist + 4 * lane) = (f32x4){0.f, 0.f, 0.f, 0.f};
#pragma unroll
        for (int i = 0; i < 32; ++i) {
            int b = (int)((mx - x[i]) * scale); b = b < 0 ? 0 : (b > 255 ? 255 : b);
            __hip_atomic_fetch_add(&hist[b], (int)((active >> i) & 1u), __ATOMIC_RELAXED, __HIP_MEMORY_SCOPE_WAVEFRONT);
        }
        const int h0 = hist[4 * lane], h1 = hist[4 * lane + 1], h2 = hist[4 * lane + 2], h3 = hist[4 * lane + 3];
        const int L = h0 + h1 + h2 + h3, incl = wave_incl_scan(L);
        const int Ls = __builtin_ctzll(__ballot(incl >= need));
        int c = __builtin_amdgcn_readlane(incl, Ls) - __builtin_amdgcn_readlane(L, Ls);
        const int g0 = __builtin_amdgcn_readlane(h0, Ls), g1 = __builtin_amdgcn_readlane(h1, Ls), g2 = __builtin_amdgcn_readlane(h2, Ls), g3 = __builtin_amdgcn_readlane(h3, Ls);
        int Bs = 4 * Ls, cnt = g0;
        if (c + g0 < need) { c += g0; Bs += 1; cnt = g1; if (c + g1 < need) { c += g1; Bs += 1; cnt = g2; if (c + g2 < need) { c += g2; Bs += 1; cnt = g3; } } }
        const float fB = (float)Bs, fB1 = (float)(Bs + 1);
        unsigned na = 0u;
#pragma unroll
        for (int i = 0; i < 32; ++i) {
            const float q = (mx - x[i]) * scale; const unsigned bit = active & (1u << i);
            const bool lt = q < fB, inb = (q >= fB) && (q < fB1 || Bs == 255);
            sel |= lt ? bit : 0u; na |= inb ? bit : 0u;
        }
        active = na; need -= c;
        if (cnt <= 64) break;
    }
    LAS f32x2* cv2 = (LAS f32x2*)cval;
    const int cmine = __builtin_popcount(active);
    int pos = wave_incl_scan(cmine) - cmine;
    const int base = __builtin_amdgcn_readlane(pos, 63) + __builtin_amdgcn_readlane(cmine, 63);
    {
        unsigned rem = active;
        while (__ballot(rem != 0u) != 0ull) {
            if (rem != 0u) { const int i = __builtin_ctz(rem); rem &= rem - 1u; cv2[pos++] = (f32x2){srow[32 * lane + i], __int_as_float(32 * lane + i)}; }
        }
    }
    const int m = base, me = lane < m ? lane : 0;
    const f32x2 mine = cv2[me]; const float v = mine.x; const int id = __float_as_int(mine.y);
    int rank = 0;
    for (int u = 0; u < m; ++u) { const f32x2 o = cv2[u]; const int iu = __float_as_int(o.y); rank += (o.x > v || (o.x == v && iu < id)) ? 1 : 0; }
    const unsigned long long hit = __ballot(lane < m && rank == need - 1);
    const int src = __builtin_ctzll(hit);
    const float P = __int_as_float(__builtin_amdgcn_readlane(__float_as_int(v), src)); const int Pidx = __builtin_amdgcn_readlane(id, src);
#pragma unroll
    for (int i = 0; i < 32; ++i) { const unsigned bit = active & (1u << i); sel |= (x[i] > P || (x[i] == P && 32 * lane + i <= Pidx)) ? bit : 0u; }
    return sel;
}
__device__ __forceinline__ void dsa_mask_phase(LAS unsigned char* lds, const Bufs& B, unsigned* MASK, int G, int vcu) {
    LAS float* sc = (LAS float*)lds;
    const int tid = threadIdx.x, lane = tid & 63, wid = __builtin_amdgcn_readfirstlane(tid >> 6), r32 = lane & 31, hi = lane >> 5;
    const int npairs = NB * 64;
    for (int pr = vcu; pr < npairs; pr += G) {
        for (int s2 = 0; s2 < 2; ++s2) {
            const int b = pr >> 6, kk = ((pr & 63) + 16 * (pr / G)) & 63, ti = s2 ? 127 - kk : kk;
            const int t0 = ti * 16, row0 = b * S + t0, nkb = (t0 + 16 + 31) >> 5;
            bf16x8 af[4][2];
            {
                const int a = r32 >> 4, bb = (r32 >> 3) & 1, c = (r32 >> 2) & 1, d = r32 & 3;
                const int tokl = 2 * c + a, head = 4 * bb + d;
#pragma unroll
                for (int rb = 0; rb < 4; ++rb)
#pragma unroll
                    for (int ks = 0; ks < 2; ++ks) af[rb][ks] = *(const bf16x8*)(B.IQ + (size_t)(row0 + 4 * rb + tokl) * 256 + head * 32 + 16 * ks + 8 * hi);
            }
            LAS float* wl = (LAS float*)(lds + 147456);
            __syncthreads();
            if (tid < 128) wl[tid] = B.IW[(size_t)row0 * 8 + tid];
            __syncthreads();
            for (int kb = wid; kb < nkb; kb += 8) {
                const int key = 32 * kb + r32;
                const bf16x8 bf0 = *(const bf16x8*)(B.IK + (size_t)(b * S + key) * 32 + 8 * hi);
                const bf16x8 bf1 = *(const bf16x8*)(B.IK + (size_t)(b * S + key) * 32 + 16 + 8 * hi);
#pragma unroll
                for (int rb = 0; rb < 4; ++rb) {
                    f32x16 acc = {};
                    acc = __builtin_amdgcn_mfma_f32_32x32x16_bf16(af[rb][0], bf0, acc, 0, 0, 0);
                    acc = __builtin_amdgcn_mfma_f32_32x32x16_bf16(af[rb][1], bf1, acc, 0, 0, 0);
#pragma unroll
                    for (int a = 0; a < 2; ++a) {
                        float sv = 0.f;
#pragma unroll
                        for (int bb = 0; bb < 2; ++bb)
                        { const f32x4 wv = *(const LAS f32x4*)(wl + (4 * rb + 2 * hi + a) * 8 + 4 * bb);
#pragma unroll
                            for (int d = 0; d < 4; ++d) sv = fmaf(wv[d], fmaxf(acc[8 * a + 4 * bb + d], 0.f), sv); }
                        sc[(4 * rb + 2 * hi + a) * 2048 + key] = sv;
                    }
                }
            }
            __syncthreads();
#pragma unroll 1
            for (int qq = 0; qq < 2; ++qq) {
                const int ql = 2 * wid + qq, t = t0 + ql, nk = t + 1;
                unsigned word;
                const int kbase = 32 * lane;
                const int nb = t - kbase + 1;
                const unsigned vm = nb >= 32 ? 0xffffffffu : (nb <= 0 ? 0u : ((1u << nb) - 1u));
                if (nk <= NKEYS) word = vm;
                else {
                    float xv[32];
#pragma unroll
                    for (int j = 0; j < 8; ++j) {
                        const f32x4 v = *(const LAS f32x4*)(sc + ql * 2048 + kbase + 4 * j);
                        xv[4 * j] = v[0]; xv[4 * j + 1] = v[1]; xv[4 * j + 2] = v[2]; xv[4 * j + 3] = v[3];
                    }
                    word = select_word(xv, vm, lane, (LAS int*)(lds + 131072 + wid * 2048), (LAS float*)(lds + 131072 + wid * 2048 + 1024), sc + ql * 2048);
                }
                MASK[(size_t)(row0 + ql) * 64 + lane] = word;
            }
        }
    }
    __syncthreads();
}

namespace att {
typedef short s16x4 __attribute__((ext_vector_type(4)));
typedef short v4i16_t __attribute__((ext_vector_type(4)));
constexpr int NW = 8, QBLK = 32, QB = QBLK * NW, KVBLK = 64, NQB = S / QB, DMQ = 512, DMK = 64, DMO = 1024;
constexpr float C2 = 0.125f * 1.4426950408889634f;
constexpr float NEGM = -1.0e30f, MFLOOR = -1.0e5f;
constexpr int THR = 8;
constexpr int SLOTB = 8192, LDS_K = 0, LDS_V = 3 * SLOTB, LDS_WS = 6 * SLOTB, LDS_OST = LDS_WS + NW * 256, LDS_MK = LDS_OST + NW * 4096, LDS_END = LDS_MK + 32 * 2048;
#define SBAR() __builtin_amdgcn_sched_barrier(0)
#define PIN(x) asm volatile("" : "+v"(x))
#define MFMA32(a, b, c) __builtin_amdgcn_mfma_f32_32x32x16_bf16(a, b, c, 0, 0, 0)
#define WAIT_BAR(N) asm volatile("s_waitcnt vmcnt(" #N ") lgkmcnt(0)\n\ts_barrier" ::: "memory")
__device__ __forceinline__ int crow(int r, int hi) { return (r & 3) + 8 * (r >> 2) + 4 * hi; }
__device__ __forceinline__ unsigned cvtpk(float lo, float hi) { unsigned r; asm("v_cvt_pk_bf16_f32 %0, %1, %2" : "=v"(r) : "v"(lo), "v"(hi)); return r; }
__device__ __forceinline__ void glds16(const void* g, unsigned lds_base) {
    unsigned sv; asm volatile("s_mov_b32 %0, m0\n\ts_mov_b32 m0, %2\n\ts_nop 0\n\tglobal_load_lds_dwordx4 %1, off\n\ts_mov_b32 m0, %0" : "=&s"(sv) : "v"(g), "s"(lds_base) : "memory"); }
typedef LAS const char* lds_cptr;
__device__ __forceinline__ void kload2(bf16x8* kf, lds_cptr kp, int d0) { kf[2 * d0] = *(const LAS bf16x8*)(kp + d0 * 2048); kf[2 * d0 + 1] = *(const LAS bf16x8*)(kp + d0 * 2048 + 512); }
__device__ __forceinline__ s16x4 vtr(lds_cptr p) { return __builtin_bit_cast(s16x4, __builtin_amdgcn_ds_read_tr16_b64_v4i16((LAS v4i16_t*)p)); }
#define MX3(a, b, c) __builtin_fmaxf(__builtin_fmaxf((a), (b)), (c))
__device__ __forceinline__ float rowmax(const f32x16& p0, const f32x16& p1) {
    float a = MX3(p0[0], p0[1], p1[0]), b = MX3(p0[2], p0[3], p1[1]); a = MX3(a, p1[2], p1[3]);
#pragma unroll
    for (int r = 4; r < 16; r += 4) { a = MX3(a, p0[r], p0[r + 1]); b = MX3(b, p0[r + 2], p0[r + 3]); a = MX3(a, p1[r], p1[r + 1]); b = MX3(b, p1[r + 2], p1[r + 3]); }
    float m = __builtin_fmaxf(a, b); auto rr = __builtin_amdgcn_permlane32_swap(__float_as_uint(m), __float_as_uint(m), false, false);
    return __builtin_fmaxf(__uint_as_float(rr[0]), __uint_as_float(rr[1])); }
__device__ __forceinline__ void amask(f32x16& p0, f32x16& p1, unsigned w0, unsigned w1, int hi) {
    const unsigned a = w0 >> (4 * hi), b = w1 >> (4 * hi);
#pragma unroll
    for (int r = 0; r < 16; ++r) { const int bit = (r & 3) + 8 * (r >> 2); if (!((a >> bit) & 1u)) p0[r] = NEGM; if (!((b >> bit) & 1u)) p1[r] = NEGM; } }

__device__ __forceinline__ void attn_unit(int b, int h, int qb, const bf16_t* Q, const bf16_t* __restrict__ K, const bf16_t* __restrict__ V, const unsigned* __restrict__ MASK, bf16_t* O, LAS char* lds) {
    const int tid = threadIdx.x, lane = tid & 63, r32 = lane & 31, hi = lane >> 5; const int wid = __builtin_amdgcn_readfirstlane(tid >> 6);
    const long rowbase = (long)b * S; const int q0 = qb * QB, NT = (q0 + QB) / KVBLK;
    const bf16_t* Qw = Q + (rowbase + q0 + wid * QBLK) * DMQ + h * 64;
    const unsigned lds0 = (unsigned)(uintptr_t)lds; LAS float* wsf = (LAS float*)(lds + LDS_WS) + wid * 64;
    {
        const unsigned* mrow = MASK + (size_t)(rowbase + q0 + (tid >> 1)) * 64 + (tid & 1) * 32;
        u32x4 mv[8];
#pragma unroll
        for (int j = 0; j < 8; ++j) mv[j] = *(const u32x4*)(mrow + 4 * j);
#pragma unroll
        for (int j = 0; j < 8; ++j) {
            const int tl = (tid & 1) * 16 + 2 * j;
            *(LAS u32x2*)(lds + LDS_MK + tl * 2048 + (tid >> 1) * 8) = (u32x2){mv[j].x, mv[j].y};
            *(LAS u32x2*)(lds + LDS_MK + (tl + 1) * 2048 + (tid >> 1) * 8) = (u32x2){mv[j].z, mv[j].w};
        }
    }
    const LAS char* mkp = lds + LDS_MK + (wid * QBLK + r32) * 8;
    const bf16_t* ksrc = K + rowbase * DMK + (long)lane * DMK + wid * 8;
    const bf16_t* vsrc = V + rowbase * DMK + (long)(16 * (wid & 3) + (lane >> 2)) * DMK + (wid >> 2) * 32 + (lane & 3) * 8;
    const unsigned kdst = lds0 + LDS_K + wid * 1024, vdst = lds0 + LDS_V + wid * 1024;
#define DMA_K(t, slot) glds16(ksrc + (long)(t) * KVBLK * DMK, (unsigned)__builtin_amdgcn_readfirstlane(kdst + (slot)))
#define DMA_V(t, slot) glds16(vsrc + (long)(t) * KVBLK * DMK, (unsigned)__builtin_amdgcn_readfirstlane(vdst + (slot)))
    const lds_cptr vp0 = (lds_cptr)lds + LDS_V + ((lane >> 4) & 1) * 32 + (lane & 3) * 8 + (4 * hi + ((lane & 15) >> 2)) * 64;
    const lds_cptr kp0 = (lds_cptr)lds + LDS_K + hi * 1024 + r32 * 16;
    asm volatile("s_waitcnt vmcnt(0)" ::: "memory");
    DMA_K(0, 0); DMA_V(0, 0); DMA_K(1, SLOTB);
    bf16x8 qr[4];
#pragma unroll
    for (int d0 = 0; d0 < 4; ++d0) qr[d0] = *reinterpret_cast<const bf16x8*>(&Qw[(long)r32 * DMQ + d0 * 16 + hi * 8]);
    float mhat = 0.f, l_reg = 0.f; f32x16 o[2]; o[0] = f32x16{}; o[1] = f32x16{};
    const f32x16 zero16 = f32x16{};
    bool resc = false;
    f32x16 pA0, pA1, pB0, pB1; bf16x8 kf[8]; s16x4 vlo[8], vhi[8]; u32x4 pw0, pw1, pw2, pw3;
    int sl_prev = 0, sl_cur = 0, sl_next = SLOTB;
#define ROT() do { sl_prev = sl_cur; sl_cur = sl_next; sl_next = (sl_next == 2 * SLOTB) ? 0 : sl_next + SLOTB; } while (0)
#define EX(v) __builtin_amdgcn_exp2f(__builtin_fmaf((v), C2, nmh))
#define RESC() do { if (resc) { _Pragma("unroll") for (int d_ = 0; d_ < 2; ++d_) _Pragma("unroll") for (int r = 0; r < 16; ++r) o[d_][r] *= wsf[crow(r, hi)]; } } while (0)
    DMA_K(2, 2 * SLOTB);
    WAIT_BAR(3);
    _Pragma("unroll") for (int d0 = 0; d0 < 4; ++d0) kload2(kf, kp0, d0);
    pA0 = MFMA32(kf[0], qr[0], zero16); pA1 = MFMA32(kf[1], qr[0], zero16); pA0 = MFMA32(kf[2], qr[1], pA0); pA1 = MFMA32(kf[3], qr[1], pA1);
    pA0 = MFMA32(kf[4], qr[2], pA0); pA1 = MFMA32(kf[5], qr[2], pA1); pA0 = MFMA32(kf[6], qr[3], pA0); pA1 = MFMA32(kf[7], qr[3], pA1);
    { const u32x2 mw = *(const LAS u32x2*)(mkp); amask(pA0, pA1, mw.x, mw.y, hi); }
    { const float rm = rowmax(pA0, pA1); mhat = __builtin_fmaxf(rm * C2, MFLOOR); const float nmh = -mhat;
#pragma unroll
      for (int r = 0; r < 16; ++r) { pA0[r] = EX(pA0[r]); pA1[r] = EX(pA1[r]); } }
    WAIT_BAR(0);
    DMA_K(3, 0); DMA_V(1, SLOTB); ROT();
    _Pragma("unroll") for (int d0 = 0; d0 < 4; ++d0) kload2(kf, kp0 + sl_cur, d0);
    WAIT_BAR(2);
#define PKW(P, i) cvtpk(P[i], P[i + 1])
#define PAF(k) __builtin_bit_cast(bf16x8, pw##k)
#define VFR(i) (bf16x8){vlo[i][0], vlo[i][1], vlo[i][2], vlo[i][3], vhi[i][0], vhi[i][1], vhi[i][2], vhi[i][3]}
#define VRD(i) do { vlo[i] = vtr(vp_ + (((i) >> 2) * 4096 + ((i) & 3) * 1024)); vhi[i] = vtr(vp_ + (((i) >> 2) * 4096 + ((i) & 3) * 1024 + 512)); } while (0)
#define KRD(G, d0) do { if (G) { kload2(kf, kp0 + sl_next, d0); SBAR(); } } while (0)
#define GAPA(MF, a0, a1, a2, a3, W0, W1, PW) do { MF; sacc += a0; sacc += a1; sacc += a2; sacc += a3; W0; W1; PIN(PW); PIN(sacc); SBAR(); } while (0)
#define GAPB(MF, X, i) do { MF; X[i] = EX(X[i]); X[i + 1] = EX(X[i + 1]); X[i + 2] = EX(X[i + 2]); X[i + 3] = EX(X[i + 3]); PIN(X); SBAR(); } while (0)
#define STEP(C0, C1, P0, P1, t, GK, GV, GL) do { SBAR(); \
    const lds_cptr vp_ = vp0 + sl_prev; const u32x2 mw_ = *(const LAS u32x2*)(mkp + (t) * 2048); \
    VRD(0); SBAR(); float sacc = P0[0] + P0[1]; \
                    GAPA(C0 = MFMA32(kf[0], qr[0], zero16), P0[2], P0[3], P0[4], P0[5],     pw0[0] = PKW(P0, 0),  pw0[1] = PKW(P0, 2),  pw0); \
    VRD(4); SBAR(); GAPA(C1 = MFMA32(kf[1], qr[0], zero16), P0[6], P0[7], P0[8], P0[9],     pw0[2] = PKW(P0, 4),  pw0[3] = PKW(P0, 6),  pw0); \
    VRD(1); SBAR(); GAPA(C0 = MFMA32(kf[2], qr[1], C0),    P0[10], P0[11], P0[12], P0[13], pw1[0] = PKW(P0, 8),  pw1[1] = PKW(P0, 10), pw1); \
    VRD(5); SBAR(); GAPA(C1 = MFMA32(kf[3], qr[1], C1),    P0[14], P0[15], P1[0], P1[1],   pw1[2] = PKW(P0, 12), pw1[3] = PKW(P0, 14), pw1); \
    VRD(2); SBAR(); GAPA(C0 = MFMA32(kf[4], qr[2], C0),    P1[2], P1[3], P1[4], P1[5],     pw2[0] = PKW(P1, 0),  pw2[1] = PKW(P1, 2),  pw2); \
    VRD(6); SBAR(); GAPA(C1 = MFMA32(kf[5], qr[2], C1),    P1[6], P1[7], P1[8], P1[9],     pw2[2] = PKW(P1, 4),  pw2[3] = PKW(P1, 6),  pw2); \
    VRD(3); SBAR(); GAPA(C0 = MFMA32(kf[6], qr[3], C0),    P1[10], P1[11], P1[12], P1[13], pw3[0] = PKW(P1, 8),  pw3[1] = PKW(P1, 10), pw3); \
    VRD(7); SBAR(); GAPA(C1 = MFMA32(kf[7], qr[3], C1),    P1[14], P1[15], 0.f, 0.f,       pw3[2] = PKW(P1, 12), pw3[3] = PKW(P1, 14), pw3); \
    l_reg += sacc; \
    if (GK) DMA_K((t) + 3, sl_cur); if (GV) DMA_V((t) + 1, sl_next); \
    amask(C0, C1, mw_.x, mw_.y, hi); \
    { const float rm = __builtin_fmaf(rowmax(C0, C1), C2, -mhat); resc = false; \
      if (__builtin_expect(__any(rm > (float)THR), 0)) { const float dl = __builtin_fmaxf(rm, 0.f); mhat += dl; \
          const float f = __builtin_amdgcn_exp2f(-dl); l_reg *= f; if (hi == 0) wsf[r32] = f; resc = true; } } \
    const float nmh = -mhat; SBAR(); \
    GAPB(o[0] = MFMA32(PAF(0), VFR(0), o[0]), C0, 0);              GAPB(o[1] = MFMA32(PAF(0), VFR(4), o[1]), C0, 4); \
    KRD(GL, 0); GAPB(o[0] = MFMA32(PAF(1), VFR(1), o[0]), C0, 8);  KRD(GL, 1); GAPB(o[1] = MFMA32(PAF(1), VFR(5), o[1]), C0, 12); \
    KRD(GL, 2); GAPB(o[0] = MFMA32(PAF(2), VFR(2), o[0]), C1, 0);  KRD(GL, 3); GAPB(o[1] = MFMA32(PAF(2), VFR(6), o[1]), C1, 4); \
    GAPB(o[0] = MFMA32(PAF(3), VFR(3), o[0]), C1, 8);              GAPB(o[1] = MFMA32(PAF(3), VFR(7), o[1]), C1, 12); \
    } while (0)
    int t = 1;
    for (; t + 5 < NT; t += 2) {
        STEP(pB0, pB1, pA0, pA1, t, true, true, true);     WAIT_BAR(2); RESC(); ROT();
        STEP(pA0, pA1, pB0, pB1, t + 1, true, true, true); WAIT_BAR(2); RESC(); ROT();
    }
#define ENDW(tt) do { if ((tt) + 3 < NT) { WAIT_BAR(2); } else if ((tt) + 2 < NT) { WAIT_BAR(1); } else { WAIT_BAR(0); } } while (0)
    for (; t + 1 < NT; t += 2) {
        STEP(pB0, pB1, pA0, pA1, t, (t + 3 < NT), (t + 1 < NT), (t + 1 < NT));         ENDW(t);     RESC(); ROT();
        STEP(pA0, pA1, pB0, pB1, t + 1, (t + 4 < NT), (t + 2 < NT), (t + 2 < NT));     ENDW(t + 1); RESC(); ROT();
    }
    STEP(pB0, pB1, pA0, pA1, NT - 1, false, false, false); RESC();
    { float sacc = pB0[0] + pB0[1];
#pragma unroll
      for (int r = 2; r < 16; ++r) sacc += pB0[r];
#pragma unroll
      for (int r = 0; r < 16; ++r) sacc += pB1[r];
      l_reg += sacc;
      pw0 = (u32x4){PKW(pB0, 0), PKW(pB0, 2), PKW(pB0, 4), PKW(pB0, 6)}; pw1 = (u32x4){PKW(pB0, 8), PKW(pB0, 10), PKW(pB0, 12), PKW(pB0, 14)};
      pw2 = (u32x4){PKW(pB1, 0), PKW(pB1, 2), PKW(pB1, 4), PKW(pB1, 6)}; pw3 = (u32x4){PKW(pB1, 8), PKW(pB1, 10), PKW(pB1, 12), PKW(pB1, 14)};
      const lds_cptr vp_ = vp0 + sl_cur; _Pragma("unroll") for (int i = 0; i < 8; ++i) VRD(i);
      o[0] = MFMA32(PAF(0), VFR(0), o[0]); o[1] = MFMA32(PAF(0), VFR(4), o[1]); o[0] = MFMA32(PAF(1), VFR(1), o[0]); o[1] = MFMA32(PAF(1), VFR(5), o[1]);
      o[0] = MFMA32(PAF(2), VFR(2), o[0]); o[1] = MFMA32(PAF(2), VFR(6), o[1]); o[0] = MFMA32(PAF(3), VFR(3), o[0]); o[1] = MFMA32(PAF(3), VFR(7), o[1]); }
    { auto rr = __builtin_amdgcn_permlane32_swap(__float_as_uint(l_reg), __float_as_uint(l_reg), false, false); l_reg = __uint_as_float(rr[0]) + __uint_as_float(rr[1]); }
    if (hi == 0) wsf[32 + r32] = l_reg; asm volatile("s_waitcnt lgkmcnt(0)" ::: "memory");
    float rli[16];
#pragma unroll
    for (int r = 0; r < 16; ++r) rli[r] = __builtin_amdgcn_rcpf(wsf[32 + crow(r, hi)]);
    bf16_t* Ow = O + (rowbase + q0 + wid * QBLK) * DMO + h * 64; LAS bf16_t* stg = (LAS bf16_t*)(lds + LDS_OST) + wid * 2048;
#pragma unroll
    for (int r = 0; r < 16; ++r) { const int orow = crow(r, hi);
#pragma unroll
        for (int d0 = 0; d0 < 2; ++d0) stg[orow * 64 + d0 * 32 + r32] = (bf16_t)f2bf(o[d0][r] * rli[r]); }
    asm volatile("s_waitcnt lgkmcnt(0)" ::: "memory");
#pragma unroll
    for (int i = 0; i < 4; ++i) { const int row = i * 8 + (lane >> 3), ch = lane & 7; *(u32x4*)(Ow + (long)row * DMO + ch * 8) = *(const LAS u32x4*)(stg + row * 64 + ch * 8); }
    asm volatile("s_waitcnt lgkmcnt(0)\n\ts_barrier" ::: "memory");
#undef DMA_K
#undef DMA_V
#undef ROT
#undef EX
#undef RESC
#undef PKW
#undef PAF
#undef VFR
#undef VRD
#undef KRD
#undef ENDW
#undef GAPA
#undef GAPB
#undef STEP
}
__device__ __forceinline__ void attn_phase(LAS unsigned char* lds, const Bufs& B, const unsigned* MASK, int G, int vcu, bf16_t* Odst) {
    for (int p = vcu; p < NB * NH * 4; p += G) {
        const int b = p >> 5, h = (p >> 2) & 7, j = p & 3;
#pragma unroll 1
        for (int s2 = 0; s2 < 2; ++s2) attn_unit(b, h, s2 ? NQB - 1 - j : j, B.Q, B.K, B.V, MASK, Odst, (LAS char*)lds);
    }
}
#undef SBAR
#undef PIN
#undef MFMA32
#undef WAIT_BAR
#undef MX3
}

__device__ __forceinline__ void pool_phase(LAS unsigned char* lds, const Bufs& B, int G, int vcu) {
    const int tid = threadIdx.x;
    for (int tile = vcu; tile < T / 32; tile += G) {
        const int row0 = tile * 32, t0 = row0 & (S - 1);
        __syncthreads();
        for (int q = tid; q < 47 * 64; q += 512) {
            const int lr = q >> 6, c8 = q & 63, tt = t0 - 15 + lr;
            u32x4 v = {0u, 0u, 0u, 0u};
            if (tt >= 0) v = *(const u32x4*)(B.U + (size_t)(row0 - 15 + lr) * PW + 8 * c8);
            *(LAS u32x4*)(lds + lr * 1024 + c8 * 16) = v;
        }
        __syncthreads();
#pragma unroll
        for (int it = 0; it < 4; ++it) {
            const int item = it * 512 + tid, tl = item >> 6, c8 = item & 63, t = t0 + tl;
            const int win = 2 << (c8 >> 4);
            const int n = (t + 1 < win) ? t + 1 : win;
            f32x4 s0 = {0.f, 0.f, 0.f, 0.f}, s1 = {0.f, 0.f, 0.f, 0.f}, u0, u1;
            { const u32x4 w = *(const LAS u32x4*)(lds + (15 + tl) * 1024 + c8 * 16); unpack8(w, u0, u1); }
            for (int j = 0; j < win; ++j) { f32x4 a, b; const u32x4 w = *(const LAS u32x4*)(lds + (15 + tl - j) * 1024 + c8 * 16); unpack8(w, a, b); s0 += a; s1 += b; }
            const float inv = __builtin_amdgcn_rcpf((float)n);
            *(u32x4*)(B.YC + (size_t)(row0 + tl) * 1024 + 512 + 8 * c8) = pack8(s0 * inv - u0, s1 * inv - u1);
        }
    }
    __syncthreads();
}
__device__ __forceinline__ void router_phase(LAS unsigned char* lds, const float* x2, const float* g2, const float* br, const Bufs& B, int G, int vcu) {
    const int tid = threadIdx.x, lane = tid & 63, wid = __builtin_amdgcn_readfirstlane(tid >> 6), tl = lane & 15, kg = lane >> 4;
    LAS float* lgs = (LAS float*)lds + wid * (16 * 33);
    LAS int* cntl = (LAS int*)(lds + 32768);
    LAS int* basel = cntl + 32;
    LAS int* asg = basel + 32;
    LAS float* gl = (LAS float*)(asg + 512);
    LAS float* rl_ = gl + 512;
    for (int chunk = vcu; chunk < T / 128; chunk += G) {
        if (tid < 32) cntl[tid] = 0;
        __syncthreads();
        const int tok = chunk * 128 + wid * 16 + tl;
        f32x4 acc0 = {0.f, 0.f, 0.f, 0.f}, acc1 = {0.f, 0.f, 0.f, 0.f}; float ss = 0.f;
        const bf16_t* wh0 = B.WRH + (size_t)tl * D + 8 * kg; const bf16_t* wl0 = B.WRL + (size_t)tl * D + 8 * kg;
        LAS float* xt = (LAS float*)(lds + 40960 + wid * 8448);
        const float* xsrc = x2 + (size_t)(chunk * 128 + wid * 16 + (lane >> 5)) * D + 4 * (lane & 31);
        f32x4 xa_[8], xb_[8];
#pragma unroll
        for (int i = 0; i < 8; ++i) xa_[i] = *(const f32x4*)(xsrc + (size_t)(2 * i) * D);
#define ROUTER_CHUNK(CUR, NXT, c) do { \
            if ((c) + 1 < 8) { _Pragma("unroll") for (int i = 0; i < 8; ++i) NXT[i] = *(const f32x4*)(xsrc + (size_t)(2 * i) * D + 128 * ((c) + 1)); } \
            _Pragma("unroll") for (int i = 0; i < 8; ++i) *(LAS f32x4*)(xt + (2 * i + (lane >> 5)) * 132 + 4 * (lane & 31)) = CUR[i]; \
            asm volatile("s_waitcnt lgkmcnt(0)" ::: "memory"); \
            _Pragma("unroll") for (int k4 = 0; k4 < 4; ++k4) { const int ks = 4 * (c) + k4; \
                const f32x4 xa = *(const LAS f32x4*)(xt + tl * 132 + 32 * k4 + 8 * kg), xb = *(const LAS f32x4*)(xt + tl * 132 + 32 * k4 + 8 * kg + 4); \
                const f32x4 ga = *(const f32x4*)(g2 + 32 * ks + 8 * kg), gb = *(const f32x4*)(g2 + 32 * ks + 8 * kg + 4); \
                ss += xa[0] * xa[0] + xa[1] * xa[1] + xa[2] * xa[2] + xa[3] * xa[3] + xb[0] * xb[0] + xb[1] * xb[1] + xb[2] * xb[2] + xb[3] * xb[3]; \
                const f32x4 va = xa * ga, vb = xb * gb; \
                u32x4 hw, lw; \
                { unsigned h[8]; float lo[8]; \
                  _Pragma("unroll") for (int j = 0; j < 4; ++j) { h[j] = f2bf(va[j]); lo[j] = va[j] - bf2f(h[j]); h[4 + j] = f2bf(vb[j]); lo[4 + j] = vb[j] - bf2f(h[4 + j]); } \
                  hw.x = h[0] | (h[1] << 16); hw.y = h[2] | (h[3] << 16); hw.z = h[4] | (h[5] << 16); hw.w = h[6] | (h[7] << 16); \
                  lw.x = pk2(lo[0], lo[1]); lw.y = pk2(lo[2], lo[3]); lw.z = pk2(lo[4], lo[5]); lw.w = pk2(lo[6], lo[7]); } \
                *(u32x2*)(B.H8 + (size_t)tok * D + 32 * ks + 8 * kg) = (u32x2){pk4_fp8(va[0], va[1], va[2], va[3]), pk4_fp8(vb[0], vb[1], vb[2], vb[3])}; \
                const bf16x8 bh = __builtin_bit_cast(bf16x8, hw), bl = __builtin_bit_cast(bf16x8, lw); \
                const bf16x8 ah0 = *(const bf16x8*)(wh0 + 32 * ks), al0 = *(const bf16x8*)(wl0 + 32 * ks); \
                const bf16x8 ah1 = *(const bf16x8*)(wh0 + 16 * D + 32 * ks), al1 = *(const bf16x8*)(wl0 + 16 * D + 32 * ks); \
                acc0 = __builtin_amdgcn_mfma_f32_16x16x32_bf16(ah0, bh, acc0, 0, 0, 0); acc0 = __builtin_amdgcn_mfma_f32_16x16x32_bf16(ah0, bl, acc0, 0, 0, 0); acc0 = __builtin_amdgcn_mfma_f32_16x16x32_bf16(al0, bh, acc0, 0, 0, 0); \
                acc1 = __builtin_amdgcn_mfma_f32_16x16x32_bf16(ah1, bh, acc1, 0, 0, 0); acc1 = __builtin_amdgcn_mfma_f32_16x16x32_bf16(ah1, bl, acc1, 0, 0, 0); acc1 = __builtin_amdgcn_mfma_f32_16x16x32_bf16(al1, bh, acc1, 0, 0, 0); } \
            asm volatile("s_waitcnt lgkmcnt(0)" ::: "memory"); } while (0)
#pragma unroll 1
        for (int c2 = 0; c2 < 8; c2 += 2) { ROUTER_CHUNK(xa_, xb_, c2); ROUTER_CHUNK(xb_, xa_, c2 + 1); }
#undef ROUTER_CHUNK
        ss += __shfl_xor(ss, 16); ss += __shfl_xor(ss, 32);
        const float r = rsqrtf(ss * (1.0f / D) + EPS);
        if (kg == 0) rl_[wid * 16 + tl] = r;
#pragma unroll
        for (int j = 0; j < 4; ++j) { lgs[tl * 33 + 4 * kg + j] = acc0[j] * r + br[4 * kg + j]; lgs[tl * 33 + 16 + 4 * kg + j] = acc1[j] * r + br[16 + 4 * kg + j]; }
        asm volatile("s_waitcnt lgkmcnt(0)" ::: "memory");
        if (lane < 16) {
            LAS float* lv = lgs + lane * 33;
            float v0 = 0.f, sum = 0.f; float ex[TOPK]; int ei[TOPK];
#pragma unroll
            for (int k = 0; k < TOPK; ++k) {
                int bi = 0; float bv = -3.0e38f;
                for (int e = 0; e < NE; ++e) { const float q = lv[e]; if (q > bv) { bv = q; bi = e; } }
                lv[bi] = -3.0e38f;
                if (k == 0) v0 = bv;
                ex[k] = __expf(bv - v0); sum += ex[k]; ei[k] = bi;
            }
            const float inv = 1.0f / sum;
#pragma unroll
            for (int k = 0; k < TOPK; ++k) {
                const int lr = __hip_atomic_fetch_add(&cntl[ei[k]], 1, __ATOMIC_RELAXED, __HIP_MEMORY_SCOPE_WORKGROUP);
                asg[(wid * 16 + lane) * 4 + k] = ei[k] | (lr << 8);
                gl[(wid * 16 + lane) * 4 + k] = ex[k] * inv;
            }
        }
        __syncthreads();
        if (tid < 32) basel[tid] = atomicAdd(&B.CNT[tid], cntl[tid]);
        __syncthreads();
        { const int v = asg[tid], e = v & 255, lr = v >> 8; const size_t pos = (size_t)e * T + basel[e] + lr;
          B.LIST[pos] = (chunk * 128 + (tid >> 2)) * 4 + (tid & 3); B.LISTG[pos] = gl[tid]; B.LISTR[pos] = rl_[tid >> 2]; }
        __syncthreads();
    }
}
__device__ __forceinline__ void combine_phase(float* out, const float* g, const Bufs& B, int G, int vcu) {
    const int lane = threadIdx.x & 63, gw = vcu * 8 + (threadIdx.x >> 6), NGW = G * 8;
    for (int row = gw; row < T; row += NGW) {
        f32x4* xr = (f32x4*)(out + (size_t)row * D) + lane;
        f32x4 v[4]; float s = 0.f;
#pragma unroll
        for (int j = 0; j < 4; ++j) {
            v[j] = xr[64 * j];
#pragma unroll
            for (int k = 0; k < 4; ++k) { const unsigned w = ((const unsigned*)((const fp8_t*)B.Y4 + ((size_t)row * 4 + k) * D))[lane + 64 * j];
                const f32x2 lo = __builtin_amdgcn_cvt_pk_f32_fp8((int)w, false), hi = __builtin_amdgcn_cvt_pk_f32_fp8((int)w, true);
                v[j].x += lo[0] * 0.125f; v[j].y += lo[1] * 0.125f; v[j].z += hi[0] * 0.125f; v[j].w += hi[1] * 0.125f; }
            s += v[j].x * v[j].x + v[j].y * v[j].y + v[j].z * v[j].z + v[j].w * v[j].w;
        }
        const float r = rsqrtf(wave_sum(s) * (1.0f / D) + EPS);
#pragma unroll
        for (int j = 0; j < 4; ++j) { const f32x4 gg = ((const f32x4*)g)[lane + 64 * j]; xr[64 * j] = v[j] * r * gg; }
    }
}

#define XB_TMO      128
#define XB_XCNT(j)  (256  + 64 * (j))
#define XB_XSUB(j)  (1280 + 64 * (j))
#define XB_XGEN(j)  (2304 + 64 * (j))
#define XB_TOP      3328
#define XB_TOPGEN   3392
#define XCD_BAR_WORDS 3456
#define XB_SPIN_CAP (1u << 18)
__device__ __forceinline__ unsigned xb_ld(unsigned* p)              { return __hip_atomic_load(p, __ATOMIC_RELAXED, __HIP_MEMORY_SCOPE_AGENT); }
__device__ __forceinline__ unsigned xb_add(unsigned* p, unsigned v) { return __hip_atomic_fetch_add(p, v, __ATOMIC_RELAXED, __HIP_MEMORY_SCOPE_AGENT); }
__device__ __forceinline__ unsigned xb_xcc_id() { return (unsigned)__builtin_amdgcn_s_getreg((3 << 11) | 20) & 0xFu; }
#define XB_SPIN(cond, bar) do { unsigned _sp = 0; while (cond) { __builtin_amdgcn_s_sleep(1); \
    if ((++_sp & 255u) == 0u) { if (xb_ld(&(bar)[XB_TMO])) break; if (_sp > XB_SPIN_CAP) { atomicAdd(&(bar)[XB_TMO], 1u); break; } } } } while (0)
struct XcdBarrier { unsigned* bar; unsigned x; volatile LAS unsigned* st; };
__device__ __forceinline__ XcdBarrier xcd_barrier_post(unsigned* bar, volatile LAS unsigned* st) {
    XcdBarrier b; b.bar = bar; b.x = xb_xcc_id(); b.st = st;
    if (threadIdx.x == 0) (void)xb_add(&bar[XB_XCNT(b.x)], 1u);
    return b;
}
__device__ __forceinline__ void xcd_barrier_complete(unsigned* bar, unsigned x, unsigned& nloc, unsigned& nx) {
    const unsigned G = gridDim.x * gridDim.y * gridDim.z;
    unsigned sum, cnt, mine, sp = 0u;
    for (;;) {
        sum = 0u; cnt = 0u; mine = 0u;
#pragma unroll
        for (unsigned j = 0; j < 16; ++j) { const unsigned c = xb_ld(&bar[XB_XCNT(j)]); sum += c; cnt += (c > 0u) ? 1u : 0u; mine = (j == x) ? c : mine; }
        if (sum == G) break;
        __builtin_amdgcn_s_sleep(1);
        if ((++sp & 255u) == 0u) { if (xb_ld(&bar[XB_TMO])) break; if (sp > XB_SPIN_CAP) { atomicAdd(&bar[XB_TMO], 1u); break; } }
    }
    nloc = mine > 0u ? mine : 1u; nx = cnt > 0u ? cnt : 1u;
}
__device__ __forceinline__ void xcd_barrier(const XcdBarrier& b) {
    asm volatile("s_waitcnt vmcnt(0)" ::: "memory");
    __syncthreads();
    if (threadIdx.x == 0) {
        unsigned* bar = b.bar;
        __builtin_amdgcn_s_waitcnt(0);
        unsigned nloc = b.st[0], nx = b.st[1];
        if (nloc == 0u) { xcd_barrier_complete(bar, b.x, nloc, nx); b.st[0] = nloc; b.st[1] = nx; }
        const unsigned old = xb_add(&bar[XB_XSUB(b.x)], 1u);
        const unsigned gen = old / nloc;
        if (old + 1u == (gen + 1u) * nloc) {
            __builtin_amdgcn_fence(__ATOMIC_RELEASE, "agent");
            asm volatile("s_waitcnt vmcnt(0)" ::: "memory");
            const unsigned og = xb_add(&bar[XB_TOP], 1u);
            const unsigned tg = og / nx;
            if (og + 1u == (tg + 1u) * nx) xb_add(&bar[XB_TOPGEN], 1u);
            else XB_SPIN(xb_ld(&bar[XB_TOPGEN]) == tg, bar);
            __builtin_amdgcn_fence(__ATOMIC_ACQUIRE, "agent");
            xb_add(&bar[XB_XGEN(b.x)], 1u);
            asm volatile("s_waitcnt vmcnt(0)" ::: "memory");
        } else {
            XB_SPIN(xb_ld(&bar[XB_XGEN(b.x)]) == gen, bar);
            __builtin_amdgcn_fence(__ATOMIC_ACQUIRE, "agent");
            asm volatile("s_waitcnt vmcnt(0)" ::: "memory");
        }
    }
    __syncthreads();
}

enum { PH_PRO = 0, PH_INPROJ = 1, PH_MASK = 2, PH_ATT = 3, PH_UP = 4, PH_OUT = 5, PH_ROUTER = 6, PH_GU = 7, PH_DOWN = 8, PH_COMB = 9, PH_N = 10 };

__global__ void __launch_bounds__(512, 2) mega(Args args) {
    extern __shared__ __attribute__((aligned(16))) unsigned char lds_raw[];
    LAS unsigned char* lds = (LAS unsigned char*)lds_raw;
    const int tid = threadIdx.x, lane = tid & 63, wave = __builtin_amdgcn_readfirstlane(tid >> 6);
    const int G = gridDim.x, bx = blockIdx.x;
    const int vcu = (G % 8 == 0) ? (bx % 8) * (G / 8) + bx / 8 : bx;
    unsigned char* ws = args.ws;
    Bufs B;
    B.HB = (bf16_t*)(ws + WS_HB); B.WIN = (bf16_t*)(ws + WS_WIN); B.WA = (bf16_t*)(ws + WS_WA); B.WC = (bf16_t*)(ws + WS_WC); B.WO = (bf16_t*)(ws + WS_WO);
    B.WGU = (bf16_t*)(ws + WS_WGU); B.WD = (bf16_t*)(ws + WS_WD); B.Q = (bf16_t*)(ws + WS_Q); B.K = (bf16_t*)(ws + WS_K); B.V = (bf16_t*)(ws + WS_V);
    B.IQ = (bf16_t*)(ws + WS_IQ); B.IK = (bf16_t*)(ws + WS_IK); B.U = (bf16_t*)(ws + WS_U); B.SGA = (bf16_t*)(ws + WS_SGA); B.SGP = (bf16_t*)(ws + WS_SGP);
    B.YC = (bf16_t*)(ws + WS_YC); B.YA = (bf16_t*)(ws + WS_YA); B.MX = (bf16_t*)(ws + WS_MX); B.ACT = (bf16_t*)(ws + WS_ACT); B.Y4 = (bf16_t*)(ws + WS_Y4);
    B.IW = (float*)(ws + WS_IW); B.GATE = (float*)(ws + WS_GATE); B.LIST = (int*)(ws + WS_LIST); B.CNT = (int*)(ws + WS_CTL);
    B.WRH = (bf16_t*)(ws + WS_WRH); B.WRL = (bf16_t*)(ws + WS_WRL); B.R2 = (float*)(ws + WS_R2);
    B.H8 = (fp8_t*)(ws + WS_HB); B.WGU8 = (fp8_t*)(ws + WS_WGU); B.WD8 = (fp8_t*)(ws + WS_WD); B.ACT8 = (fp8_t*)(ws + WS_ACT); B.LISTR = (float*)(ws + WS_LISTR); B.LISTG = (float*)(ws + WS_LISTG);
    const float* x = args.in[0]; const float* norm_mix = args.in[1]; const float* w_in = args.in[2]; const float* w_pool = args.in[3]; const float* pool_scale = args.in[4];
    const float* w_attn_up = args.in[5]; const float* w_pool_up = args.in[6]; const float* w_out = args.in[7];
    const float* norm_ffn = args.in[8]; const float* w_router = args.in[9]; const float* b_router = args.in[10];
    const float* w_gate_up = args.in[11]; const float* b_gate_up = args.in[12]; const float* w_down = args.in[13]; const float* b_down = args.in[14]; const float* norm_final = args.in[15];
    const int lo = args.ph_lo, hi = args.ph_hi;
    if (tid < 4) ((LAS unsigned*)(lds + LDS_XB))[tid] = 0u;
    __syncthreads();
    const XcdBarrier xbar = xcd_barrier_post((unsigned*)(ws + WS_CTL) + CW_BAR, (volatile LAS unsigned*)(lds + LDS_XB));
#define IN(k) (lo <= (k) && (k) < hi)
#define SEAM(k) do { if (IN(k) && IN((k) + 1)) { xcd_barrier(xbar); } } while (0)

    if (IN(PH_PRO)) {
        LAS float* scr = (LAS float*)(lds + wave * 16384);
        const int gw = vcu * 8 + wave, NGW = G * 8;
        constexpr int I_IN = (D / 64) * (INP / 32), I_A = (AW / 64) * (D / 32), I_O = (D / 64) * (D / 32), I_GU = (D / 64) * (F2 / 32), I_D = (D / 64) * (D / 32);
        constexpr int NITEMS = I_IN + I_A + I_O + NE * I_GU + NE * I_D;
        for (int it = gw; it < NITEMS; it += NGW) {
            int r = it;
            if (r < I_IN) { transpose_item<1>(w_in, D, INC, B.WIN, scr, r, INP / 32, lane); continue; } r -= I_IN;
            if (r < I_A) { transpose_item<0>(w_attn_up, AW, D, B.WA, scr, r, D / 32, lane); continue; } r -= I_A;
            if (r < I_O) { transpose_item<0>(w_out, D, D, B.WO, scr, r, D / 32, lane); continue; } r -= I_O;
            if (r < NE * I_GU) { const int e = r / I_GU; transpose_item_f8<2>(w_gate_up + (size_t)e * D * F2, D, F2, B.WGU8 + (size_t)e * F2 * D, scr, r % I_GU, F2 / 32, lane); continue; } r -= NE * I_GU;
            { const int e = r / I_D; transpose_item_f8<0>(w_down + (size_t)e * D * D, D, D, B.WD8 + (size_t)e * D * D, scr, r % I_D, D / 32, lane); }
        }
        for (int idx = (vcu * 512 + tid); idx < D * PW; idx += G * 512) {
            const int n = idx & (D - 1), k = idx >> 10, g = k >> 7;
            const float* wp = w_pool + (size_t)k * 128; const float* ps = pool_scale + g * 128; const float* wu = w_pool_up + (size_t)(g * 128) * D + n;
            float a = 0.f;
            for (int d = 0; d < 128; ++d) a = fmaf(wp[d] * ps[d], wu[(size_t)d * D], a);
            B.WC[(size_t)n * PW + k] = (bf16_t)f2bf(a);
        }
        for (int idx = vcu * 512 + tid; idx < NE * D; idx += G * 512) { const int e = idx >> 10, k = idx & (D - 1); const float w = w_router[(size_t)k * NE + e]; const unsigned hh = f2bf(w); B.WRH[idx] = (bf16_t)hh; B.WRL[idx] = (bf16_t)f2bf(w - bf2f(hh)); }
        for (int m = gw; m < T; m += NGW) {
            const f32x4* xr = (const f32x4*)(x + (size_t)m * D) + lane;
            f32x4 v[4]; float s = 0.f;
#pragma unroll
            for (int j = 0; j < 4; ++j) { v[j] = xr[64 * j]; s += v[j].x * v[j].x + v[j].y * v[j].y + v[j].z * v[j].z + v[j].w * v[j].w; }
            const float r = rsqrtf(wave_sum(s) * (1.0f / D) + EPS);
            u32x2* o8 = (u32x2*)(B.HB + (size_t)m * D) + lane;
#pragma unroll
            for (int j = 0; j < 4; ++j) { const f32x4 g = ((const f32x4*)norm_mix)[lane + 64 * j]; u32x2 o; o.x = pk2(v[j].x * r * g.x, v[j].y * r * g.y); o.y = pk2(v[j].z * r * g.z, v[j].w * r * g.w); o8[64 * j] = o; }
        }
    }
    SEAM(PH_PRO);
    if (IN(PH_INPROJ)) {
        pg::StaticOrder So; So.init(T, INP, G, bx, B.HB, D, B.WIN, D);
        EpiInProj E{B};
        pg::gemm_phase<EpiInProj, pg::StaticOrder, false>(lds, D, D, D, So, E);
    }
    SEAM(PH_INPROJ);
    unsigned* MASK = (unsigned*)(ws + WS_MASK);
    if (IN(PH_MASK)) {
        pool_phase(lds, B, G, vcu);
        dsa_mask_phase(lds, B, MASK, G, vcu);
    }
    SEAM(PH_MASK);
    if (IN(PH_ATT)) att::attn_phase(lds, B, MASK, G, vcu, B.YC);
    SEAM(PH_ATT);
    if (IN(PH_UP)) {
        { pg::StaticOrder So; So.init(T, D, G, bx, B.YC, D, B.WA, AW); EpiAttnUp E{B}; pg::gemm_phase<EpiAttnUp, pg::StaticOrder, false>(lds, AW, D, AW, So, E); }
        asm volatile("s_waitcnt vmcnt(0)" ::: "memory"); __syncthreads();
        { pg::StaticOrder So; So.init(T, D, G, bx, B.YC + AW, D, B.WC, PW); EpiPoolUp E{B}; pg::gemm_phase<EpiPoolUp, pg::StaticOrder, false>(lds, PW, D, PW, So, E); }
    }
    SEAM(PH_UP);
    if (IN(PH_OUT)) {
        pg::StaticOrder So; So.init(T, D, G, bx, B.MX, D, B.WO, D);
        EpiOut E{x, args.out};
        pg::gemm_phase<EpiOut, pg::StaticOrder, false>(lds, D, D, D, So, E);
    }
    SEAM(PH_OUT);
    if (IN(PH_ROUTER)) router_phase(lds, args.out, norm_ffn, b_router, B, G, vcu);
    SEAM(PH_ROUTER);
    if (IN(PH_GU)) {
        LAS int* tab = (LAS int*)(lds + LDS_TAB);
        moe_tables(tab, B.CNT, 8);
        MoeOrder Mo; Mo.tab = tab; Mo.NT = 8; Mo.G = G; Mo.c = vcu; Mo.total = tab[NE]; Mo.Abase = (const char*)B.H8; Mo.Bbase = (const char*)B.WGU8; Mo.bexp = (size_t)F2 * D; Mo.list = B.LIST; Mo.dense_a = false;
        Mo.total = __builtin_amdgcn_readfirstlane(Mo.total);
        EpiGateUp E{B.ACT8, b_gate_up, B.LISTR};
        pg::gemm_phase<EpiGateUp, MoeOrder, true, true>(lds, D / 2, D / 2, D / 2, Mo, E);
        __syncthreads();
    }
    SEAM(PH_GU);
    if (IN(PH_DOWN)) {
        LAS int* tab = (LAS int*)(lds + LDS_TAB);
        moe_tables(tab, B.CNT, 4);
        MoeOrder Mo; Mo.tab = tab; Mo.NT = 4; Mo.G = G; Mo.c = vcu; Mo.total = tab[NE]; Mo.Abase = (const char*)B.ACT8; Mo.Bbase = (const char*)B.WD8; Mo.bexp = (size_t)D * D; Mo.list = B.LIST; Mo.dense_a = true;
        Mo.total = __builtin_amdgcn_readfirstlane(Mo.total);
        EpiDown E{(fp8_t*)B.Y4, b_down, B.LISTG, B.LIST};
        pg::gemm_phase<EpiDown, MoeOrder, false, true>(lds, D / 2, D / 2, D / 2, Mo, E);
    }
    SEAM(PH_DOWN);
    if (IN(PH_COMB)) combine_phase(args.out, norm_final, B, G, vcu);
#undef IN
#undef SEAM
}

extern "C" void kernel_launch(void* const* d_in, const int* in_sizes, int n_in, void* d_out, int out_size, void* d_ws, size_t ws_size, hipStream_t stream) {
    static int grid = 0;
    if (grid == 0) {
        if (ws_size < WS_END) { fprintf(stderr, "kernel_launch: workspace too small (%zu < %zu)\n", ws_size, (size_t)WS_END); grid = -1; return; }
        int dev = 0, cus = 0, per_cu = 0;
        (void)hipGetDevice(&dev); (void)hipDeviceGetAttribute(&cus, hipDeviceAttributeMultiprocessorCount, dev);
        (void)hipFuncSetAttribute((const void*)mega, hipFuncAttributeMaxDynamicSharedMemorySize, LDS_BYTES);
        (void)hipOccupancyMaxActiveBlocksPerMultiprocessor(&per_cu, (const void*)mega, 512, LDS_BYTES);
        if (per_cu < 1) { fprintf(stderr, "kernel_launch: occupancy query says %d blocks/CU\n", per_cu); grid = -1; return; }
        grid = cus;
    }
    if (grid < 0) return;
    unsigned char* ws = (unsigned char*)d_ws;
    (void)hipMemsetAsync(ws + WS_CTL, 0, 32768, stream);
    Args a{};
    for (int i = 0; i < 16; ++i) a.in[i] = (const float*)d_in[i];
    a.out = (float*)d_out; a.ws = ws; a.ph_lo = 0; a.ph_hi = PH_N;
    void* kargs[] = {&a};
    hipError_t e = hipLaunchCooperativeKernel((const void*)mega, dim3(grid), dim3(512), kargs, LDS_BYTES, stream);
    if (e != hipSuccess) fprintf(stderr, "kernel_launch: cooperative launch failed: %s (grid %d)\n", hipGetErrorString(e), grid);
}
```

```cpp
#include <hip/hip_runtime.h>
#include <cstdio>
#include <cstdint>

#define LAS __attribute__((address_space(3)))
typedef unsigned short bf16_t;
typedef short bf16x8 __attribute__((ext_vector_type(8)));
typedef float f32x4 __attribute__((ext_vector_type(4)));
typedef float f32x2 __attribute__((ext_vector_type(2)));
typedef unsigned u32x4 __attribute__((ext_vector_type(4)));
typedef unsigned u32x2 __attribute__((ext_vector_type(2)));
typedef int i32x4 __attribute__((ext_vector_type(4)));
typedef int i32x8 __attribute__((ext_vector_type(8)));
typedef unsigned char fp8_t;

constexpr int D = 1024, NB = 16, S = 2048, T = NB * S;
constexpr int NH = 8, HD = 64, AW = 512, NIH = 8, IDD = 32, NKEYS = 256;
constexpr int PW = 512, INC = 3496, INP = 3584;
constexpr int NE = 32, TOPK = 4, F2 = 2048;
constexpr float EPS = 1e-5f;
constexpr int C_Q = 0, C_K = 512, C_V = 576, C_IQ = 640, C_IK = 896, C_IW = 928, C_U = 936, C_GA = 1448, C_GP = 2472;

constexpr size_t MiB = 1u << 20;
constexpr size_t WS_CTL = 0;
constexpr size_t WS_LIST = 1 * MiB;
constexpr size_t WS_GATE = 5 * MiB;
constexpr size_t WS_HB = 8 * MiB;
constexpr size_t WS_WIN = 72 * MiB;
constexpr size_t WS_WA = 79 * MiB;
constexpr size_t WS_WC = 80 * MiB;
constexpr size_t WS_WO = 81 * MiB;
constexpr size_t WS_WGU = 84 * MiB;
constexpr size_t WS_WD = 212 * MiB;
constexpr size_t WS_Q = 276 * MiB;
constexpr size_t WS_K = 308 * MiB;
constexpr size_t WS_V = 312 * MiB;
constexpr size_t WS_IQ = 316 * MiB;
constexpr size_t WS_IK = 332 * MiB;
constexpr size_t WS_IW = 334 * MiB;
constexpr size_t WS_U = 336 * MiB;
constexpr size_t WS_SGA = 368 * MiB;
constexpr size_t WS_SGP = 432 * MiB;
constexpr size_t WS_YC = 496 * MiB;
constexpr size_t WS_YA = 560 * MiB;
constexpr size_t WS_MX = 624 * MiB;
constexpr size_t WS_ACT = 276 * MiB;
constexpr size_t WS_Y4 = 688 * MiB;
constexpr size_t WS_WRH = 6 * MiB;
constexpr size_t WS_WRL = 6 * MiB + 65536;
constexpr size_t WS_R2 = 7 * MiB;
constexpr size_t WS_LISTR = 952 * MiB;
constexpr size_t WS_LISTG = 956 * MiB;
constexpr size_t WS_MASK = 944 * MiB;
constexpr size_t WS_END = 960 * MiB;

__device__ __forceinline__ float bf2f(unsigned b) { return __uint_as_float(b << 16); }
__device__ __forceinline__ unsigned f2bf(float f) { unsigned u = __float_as_uint(f); return (u + 0x7fffu + ((u >> 16) & 1u)) >> 16; }
__device__ __forceinline__ unsigned pk2(float lo, float hi) { return f2bf(lo) | (f2bf(hi) << 16); }
__device__ __forceinline__ unsigned cvt_pk_bf16(float lo, float hi) { unsigned r; asm volatile("v_cvt_pk_bf16_f32 %0, %1, %2" : "=v"(r) : "v"(lo), "v"(hi)); return r; }
__device__ __forceinline__ unsigned pk4_fp8(float a, float b, float c, float d) { int w = __builtin_amdgcn_cvt_pk_fp8_f32(a, b, 0, false); w = __builtin_amdgcn_cvt_pk_fp8_f32(c, d, w, true); return (unsigned)w; }
__device__ __forceinline__ float wave_sum(float v) {
#pragma unroll
    for (int o = 32; o >= 1; o >>= 1) v += __shfl_xor(v, o);
    return v;
}
__device__ __forceinline__ float wave_max(float v) {
#pragma unroll
    for (int o = 32; o >= 1; o >>= 1) v = fmaxf(v, __shfl_xor(v, o));
    return v;
}
__device__ __forceinline__ float sigmoidf_(float x) { return __builtin_amdgcn_rcpf(1.0f + __builtin_amdgcn_exp2f(-1.4426950408889634f * x)); }

__device__ __forceinline__ unsigned gate_q4(const f32x4& v) {
    unsigned q[4];
#pragma unroll
    for (int j = 0; j < 4; ++j) q[j] = (unsigned)__builtin_fmaf(255.0f, sigmoidf_(v[j]), 0.5f);
    return q[0] | (q[1] << 8) | (q[2] << 16) | (q[3] << 24);
}
__device__ __forceinline__ f32x4 gate_dq4(unsigned w) { f32x4 r; r[0] = (float)(w & 0xffu); r[1] = (float)((w >> 8) & 0xffu); r[2] = (float)((w >> 16) & 0xffu); r[3] = (float)(w >> 24); return r * (1.0f / 255.0f); }

__device__ __forceinline__ f32x4 gate_dqp4(unsigned w) { f32x4 r; r[0] = fmaxf((float)(w & 0xffu), 0.5f); r[1] = fmaxf((float)((w >> 8) & 0xffu), 0.5f); r[2] = fmaxf((float)((w >> 16) & 0xffu), 0.5f); r[3] = fmaxf((float)(w >> 24), 0.5f); return r * (1.0f / 255.0f); }

namespace pg {
constexpr int BM = 256, BK = 64, HALF = 128, HTB = HALF * BK * 2, STAGE_BYTES = 8 * HTB, NXCD = 8, WGM = 4;
__host__ __device__ __forceinline__ int lds_byte(int r, int c) { const int st = (r >> 4) * 2 + (c >> 5), rr = r & 15, cc = c & 31, ob = rr * 64 + cc * 2; return st * 1024 + (ob ^ (((ob >> 9) & 1) << 5)); }
__host__ __device__ __forceinline__ void stage_rc(int b, int& R, int& C) { const int st = b / 1024, sb = b % 1024, swz = sb ^ (((sb >> 9) & 1) << 5); R = (st >> 1) * 16 + swz / 64; C = (st & 1) * 32 + (swz % 64) / 2; }
__host__ __device__ __forceinline__ int perm32(int rho) { const int n = rho >> 4, i = rho & 15; return 8 * (i >> 2) + 4 * n + (i & 3); }

struct Unit { const char* a; const char* b; const int* rl; int nrows; int pm, pn, e; int lpos; };

struct StaticOrder {
    int nM, nN, nwg, G, c; const char* A; const char* Bt; size_t ta, tb;
    __device__ void init(int M, int N, int G_, int c_, const void* A_, int lda, const void* Bt_, int ldb) { nM = M / BM; nN = N / BM; nwg = nM * nN; G = G_; c = c_; A = (const char*)A_; Bt = (const char*)Bt_; ta = (size_t)BM * lda * 2; tb = (size_t)BM * ldb * 2; }
    __device__ bool next(int i, Unit& u) const {
        const long L = (long)i * G + c; if (L >= nwg) return false;
        int wgid = (int)L; { const int q = nwg / NXCD, r = nwg % NXCD, xcd = wgid % NXCD, off = wgid / NXCD; wgid = (xcd < r ? xcd * (q + 1) : r * (q + 1) + (xcd - r) * q) + off; }
        const int nig = WGM * nN, gid = wgid / nig, fm = gid * WGM, gsz = (nM - fm) < WGM ? (nM - fm) : WGM;
        u.pm = fm + ((wgid % nig) % gsz); u.pn = (wgid % nig) / gsz; u.e = 0; u.nrows = BM; u.rl = nullptr; u.lpos = 0;
        u.a = A + (size_t)u.pm * ta; u.b = Bt + (size_t)u.pn * tb; return true;
    }
};

template <class Epi, class Sched, bool GATHER, bool F8 = false>
__device__ __forceinline__ void gemm_phase(LAS unsigned char* lds, const int K, const int lda, const int ldb, const Sched& S, const Epi& E) {
    const int tid = threadIdx.x, wid = __builtin_amdgcn_readfirstlane(tid >> 6), lane = tid & 63, wr = wid >> 2, wc = wid & 3, fr = lane & 15, fq = lane >> 4;
    const int nt = K / BK;
    unsigned voffB[2], c0[2], c1[2], n0[2], n1[2];
    int Rs[2], Cs[2];
#pragma unroll
    for (int i = 0; i < 2; ++i) { int R, C; stage_rc(tid * 16 + i * 8192, R, C); Rs[i] = R; Cs[i] = C; const int Rb = Epi::PERM ? ((R & ~31) + perm32(R & 31)) : R;
        voffB[i] = (unsigned)(Rb * ldb + C) * 2u; c0[i] = (unsigned)(R * lda + C) * 2u; c1[i] = (unsigned)((R + HALF) * lda + C) * 2u; n0[i] = c0[i]; n1[i] = c1[i]; }
    const size_t kstep = (size_t)(BK * 2);
    const size_t hstepB = (size_t)HALF * ldb * 2;
    const unsigned ldsw = (unsigned)wid * 1024u;
    const int aoff = lds_byte(wr * 64 + fr, fq * 8), boff = lds_byte(wc * 32 + fr, fq * 8);
#define PG_GOFF(u, o0, o1) do { _Pragma("unroll") for (int _i = 0; _i < 2; ++_i) { const int _r0 = Rs[_i], _r1 = Rs[_i] + HALF; \
        const int _t0 = (u).rl[_r0 < (u).nrows ? _r0 : 0] >> 2, _t1 = (u).rl[_r1 < (u).nrows ? _r1 : 0] >> 2; \
        o0[_i] = (unsigned)(_t0 * lda + Cs[_i]) * 2u; o1[_i] = (unsigned)(_t1 * lda + Cs[_i]) * 2u; } } while (0)
#define PG_SA(b, h) (((b) * 2 + (h)) * HTB)
#define PG_SB(b, h) ((4 + (b) * 2 + (h)) * HTB)
#define PG_STAGE(bufoff, gbase, voff) do { _Pragma("unroll") for (int _i = 0; _i < 2; ++_i) \
        __builtin_amdgcn_global_load_lds((const unsigned*)((const char*)(gbase) + (voff)[_i]), (LAS unsigned*)(lds + (bufoff) + ldsw + _i * 8192), 16, 0, 0); } while (0)
#define PG_LDA(dst, b, h) do { _Pragma("unroll") for (int m = 0; m < 4; ++m) _Pragma("unroll") for (int k = 0; k < 2; ++k) dst[m][k] = *(const LAS bf16x8*)(lds + PG_SA(b, h) + aoff + m * 2048 + k * 1024); } while (0)
#define PG_LDB(dst, b, h) do { _Pragma("unroll") for (int n = 0; n < 2; ++n) _Pragma("unroll") for (int k = 0; k < 2; ++k) dst[n][k] = *(const LAS bf16x8*)(lds + PG_SB(b, h) + boff + n * 2048 + k * 1024); } while (0)
#define PG_CAT(x0, x1) __builtin_shufflevector(__builtin_bit_cast(i32x4, x0), __builtin_bit_cast(i32x4, x1), 0, 1, 2, 3, 4, 5, 6, 7)
#define PG_MMA(ai, bj, At, Bt) do { __builtin_amdgcn_s_setprio(1); \
        if constexpr (F8) { _Pragma("unroll") for (int m = 0; m < 4; ++m) _Pragma("unroll") for (int n = 0; n < 2; ++n) \
            asm volatile("v_mfma_scale_f32_16x16x128_f8f6f4 %0, %1, %2, %0, %3, %4 op_sel_hi:[0,0,0]" : "+v"(acc[ai][bj][m][n]) : "v"(PG_CAT(Bt[n][0], Bt[n][1])), "v"(PG_CAT(At[m][0], At[m][1])), "v"(sclW), "v"(sclA)); } \
        else { _Pragma("unroll") for (int m = 0; m < 4; ++m) _Pragma("unroll") for (int n = 0; n < 2; ++n) _Pragma("unroll") for (int k = 0; k < 2; ++k) \
            acc[ai][bj][m][n] = __builtin_amdgcn_mfma_f32_16x16x32_bf16(Bt[n][k], At[m][k], acc[ai][bj][m][n], 0, 0, 0); } \
        __builtin_amdgcn_s_setprio(0); } while (0)
#define PG_WAIT_V(n) asm volatile("s_waitcnt vmcnt(" #n ")" ::: "memory")
#define PG_WAIT_L(n) asm volatile("s_waitcnt lgkmcnt(" #n ")" ::: "memory")
#define PG_BAR __builtin_amdgcn_s_barrier()
#define PG_SCHED __builtin_amdgcn_sched_barrier(0)
    Unit cur, nxt; int ui = 0;
    if (!S.next(0, cur)) return;
    f32x4 acc[2][2][4][2];
#pragma unroll
    for (int a = 0; a < 2; ++a)
#pragma unroll
        for (int b = 0; b < 2; ++b)
#pragma unroll
            for (int m = 0; m < 4; ++m)
#pragma unroll
                for (int n = 0; n < 2; ++n) acc[a][b][m][n] = (f32x4){0.f, 0.f, 0.f, 0.f};
    bf16x8 At[4][2], B0[2][2], B1[2][2];
    int sclW = 0x79797979, sclA = Epi::SCLA;
    asm volatile("" : "+v"(sclW), "+v"(sclA));
    const char* cA = cur.a; const char* cB = cur.b;
    if (GATHER) PG_GOFF(cur, c0, c1);
    PG_STAGE(PG_SB(0, 0), cB, voffB); PG_STAGE(PG_SA(0, 0), cA, c0); PG_STAGE(PG_SB(0, 1), cB + hstepB, voffB); PG_STAGE(PG_SA(0, 1), cA, c1);
    if (wr == 1) PG_BAR;
    PG_WAIT_V(4); PG_BAR;
    PG_STAGE(PG_SB(1, 0), cB + kstep, voffB); PG_STAGE(PG_SA(1, 0), cA + kstep, c0); PG_STAGE(PG_SB(1, 1), cB + hstepB + kstep, voffB);
    PG_WAIT_V(6); PG_BAR;
    for (;;) {
        const bool has_next = S.next(ui + 1, nxt);
        const char* nA = has_next ? nxt.a : cA; const char* nB = has_next ? nxt.b : cB;
        if (GATHER) { if (has_next) PG_GOFF(nxt, n0, n1); else { n0[0] = c0[0]; n0[1] = c0[1]; n1[0] = c1[0]; n1[1] = c1[1]; } }
        for (int t = 0; t < nt; t += 2) {
            if constexpr (Epi::MIDK > 0) { if (t == Epi::MIDK) E.mid(acc, cur, wr, wc, fr, fq); }
            const bool last = (t == nt - 2);
            const char* a1 = cA + (size_t)(t + 1) * kstep;
            const char* a2 = last ? nA : cA + (size_t)(t + 2) * kstep; const char* b2 = last ? nB : cB + (size_t)(t + 2) * kstep;
            const char* a3 = a2 + kstep; const char* b3 = b2 + kstep;
            unsigned s0[2], s1[2];
            s0[0] = last ? n0[0] : c0[0]; s0[1] = last ? n0[1] : c0[1]; s1[0] = last ? n1[0] : c1[0]; s1[1] = last ? n1[1] : c1[1];
            PG_LDB(B0, 0, 0); PG_SCHED; PG_LDA(At, 0, 0); PG_STAGE(PG_SA(1, 1), a1, c1);
            PG_WAIT_L(8); PG_BAR; PG_WAIT_L(0); PG_MMA(0, 0, At, B0); PG_BAR; PG_SCHED;
            PG_LDB(B1, 0, 1); PG_STAGE(PG_SB(0, 0), b2, voffB);
            PG_BAR; PG_WAIT_L(0); PG_MMA(0, 1, At, B1); PG_BAR;
            PG_LDA(At, 0, 1); PG_STAGE(PG_SA(0, 0), a2, s0);
            PG_BAR; PG_WAIT_L(0); PG_MMA(1, 0, At, B0); PG_BAR; PG_SCHED;
            PG_STAGE(PG_SB(0, 1), b2 + hstepB, voffB);
            PG_WAIT_V(6); PG_BAR; PG_MMA(1, 1, At, B1); PG_BAR;
            PG_LDB(B0, 1, 0); PG_SCHED; PG_LDA(At, 1, 0); PG_STAGE(PG_SA(0, 1), a2, s1);
            PG_WAIT_L(8); PG_BAR; PG_WAIT_L(0); PG_MMA(0, 0, At, B0); PG_BAR; PG_SCHED;
            PG_LDB(B1, 1, 1); PG_STAGE(PG_SB(1, 0), b3, voffB);
            PG_BAR; PG_WAIT_L(0); PG_MMA(0, 1, At, B1); PG_BAR;
            PG_LDA(At, 1, 1); PG_STAGE(PG_SA(1, 0), a3, s0);
            PG_BAR; PG_WAIT_L(0); PG_MMA(1, 0, At, B0); PG_BAR; PG_SCHED;
            PG_STAGE(PG_SB(1, 1), b3 + hstepB, voffB);
            PG_WAIT_V(6); PG_BAR; PG_MMA(1, 1, At, B1); PG_BAR;
        }
        if constexpr (F8) asm volatile("s_nop 15\n\ts_nop 15" ::: "memory");
        E(acc, cur, wr, wc, fr, fq);
        if (!has_next) break;
#pragma unroll
        for (int a = 0; a < 2; ++a)
#pragma unroll
            for (int b = 0; b < 2; ++b)
#pragma unroll
                for (int m = 0; m < 4; ++m)
#pragma unroll
                    for (int n = 0; n < 2; ++n) acc[a][b][m][n] = (f32x4){0.f, 0.f, 0.f, 0.f};
        cur = nxt; cA = nA; cB = nB; ++ui;
        if (GATHER) { c0[0] = n0[0]; c0[1] = n0[1]; c1[0] = n1[0]; c1[1] = n1[1]; }
    }
    PG_WAIT_V(0);
    if (wr == 0) PG_BAR;
    PG_BAR;
#undef PG_GOFF
#undef PG_SA
#undef PG_SB
#undef PG_STAGE
#undef PG_LDA
#undef PG_LDB
#undef PG_MMA
#undef PG_CAT
#undef PG_WAIT_V
#undef PG_WAIT_L
#undef PG_BAR
#undef PG_SCHED
}
}

struct Bufs {
    bf16_t *HB, *WIN, *WA, *WC, *WO, *WGU, *WD, *Q, *K, *V, *IQ, *IK, *U, *SGA, *SGP, *YC, *YA, *MX, *ACT, *Y4;
    float *IW, *GATE; int* LIST; int* CNT; bf16_t *WRH, *WRL; float* R2;
    fp8_t *H8, *WGU8, *WD8, *ACT8, *H8P, *WIN8; float *LISTR, *LISTG;
};
__device__ __forceinline__ u32x4 pack8(const f32x4& v0, const f32x4& v1) { u32x4 w; w.x = cvt_pk_bf16(v0[0], v0[1]); w.y = cvt_pk_bf16(v0[2], v0[3]); w.z = cvt_pk_bf16(v1[0], v1[1]); w.w = cvt_pk_bf16(v1[2], v1[3]); return w; }
__device__ __forceinline__ void unpack8(const u32x4& w, f32x4& v0, f32x4& v1) {
    v0[0] = bf2f(w.x & 0xffffu); v0[1] = bf2f(w.x >> 16); v0[2] = bf2f(w.y & 0xffffu); v0[3] = bf2f(w.y >> 16);
    v1[0] = bf2f(w.z & 0xffffu); v1[1] = bf2f(w.z >> 16); v1[2] = bf2f(w.w & 0xffffu); v1[3] = bf2f(w.w >> 16); }

struct EpiInProj {
    static constexpr bool PERM = true; static constexpr int MIDK = 0; static constexpr int SCLA = 0x7f7f7f7f;
    Bufs B; int pn0;
    __device__ __forceinline__ void operator()(const f32x4 (&acc)[2][2][4][2], const pg::Unit& u, int wr, int wc, int fr, int fq) const {
        asm volatile("" : "+v"(fr), "+v"(fq));
        const int pn = u.pn + pn0;
        if (pn >= 6) {
            unsigned char* gb = (unsigned char*)(pn < 10 ? B.SGA : B.SGP) + ((pn - 6) & 3) * 256 + wc * 64 + fq * 16;
#pragma unroll
            for (int ai = 0; ai < 2; ++ai)
#pragma unroll
                for (int m = 0; m < 4; ++m) {
                    const size_t row = (size_t)u.pm * 256 + ai * 128 + wr * 64 + m * 16 + fr;
                    u32x4 w; w.x = gate_q4(acc[ai][0][m][0]); w.y = gate_q4(acc[ai][0][m][1]); w.z = gate_q4(acc[ai][1][m][0]); w.w = gate_q4(acc[ai][1][m][1]);
                    *(u32x4*)(gb + row * 1024) = w;
                }
            return;
        }
        bf16_t* base; int pitch, coff;
        if (pn < 2) { base = B.Q; pitch = 512; coff = pn * 256; }
        else if (pn == 3) { base = B.IQ; pitch = 256; coff = 0; }
        else { base = B.U; pitch = 512; coff = (pn - 4) * 256; }
#pragma unroll
        for (int ai = 0; ai < 2; ++ai)
#pragma unroll
            for (int m = 0; m < 4; ++m) {
                const size_t row = (size_t)u.pm * 256 + ai * 128 + wr * 64 + m * 16 + fr;
#pragma unroll
                for (int bj = 0; bj < 2; ++bj) {
                    const int cc = bj * 128 + wc * 32 + fq * 8;
                    f32x4 v0 = acc[ai][bj][m][0], v1 = acc[ai][bj][m][1];
                    if (pn == 2) {
                        if (cc < 64) *(u32x4*)(B.K + row * 64 + cc) = pack8(v0, v1);
                        else if (cc < 128) *(u32x4*)(B.V + row * 64 + (cc - 64)) = pack8(v0, v1);
                        else if (cc < 160) *(u32x4*)(B.IK + row * 32 + (cc - 128)) = pack8(v0, v1);
                        else if (cc == 160) { *(f32x4*)(B.IW + row * 8) = v0 * 0.0625f; *(f32x4*)(B.IW + row * 8 + 4) = v1 * 0.0625f; }
                    } else {
                        *(u32x4*)(base + row * pitch + coff + cc) = pack8(v0, v1);
                    }
                }
            }
    }
};
#define EPI_PIN4(v) asm volatile("" : "+v"(v))
struct EpiAttnUp {
    static constexpr bool PERM = true; static constexpr int MIDK = 0; static constexpr int SCLA = 0x7f7f7f7f;
    Bufs B;
    __device__ __forceinline__ void operator()(const f32x4 (&acc)[2][2][4][2], const pg::Unit& u, int wr, int wc, int fr, int fq) const {
        asm volatile("" : "+v"(fr), "+v"(fq));
        const size_t r0 = ((size_t)u.pm * 256 + wr * 64 + fr) * 1024 + u.pn * 256;
        const size_t o0 = r0 + wc * 32 + fq * 8;
        const unsigned char* gp = (const unsigned char*)B.SGA + r0 + wc * 64 + fq * 16;
        u32x4 g[2][4];
#pragma unroll
        for (int ai = 0; ai < 2; ++ai)
#pragma unroll
            for (int m = 0; m < 4; ++m) g[ai][m] = *(const u32x4*)(gp + (size_t)(ai * 128 + m * 16) * 1024);
        asm volatile("s_waitcnt vmcnt(0)" ::: "memory");
#pragma unroll
        for (int ai = 0; ai < 2; ++ai)
#pragma unroll
            for (int m = 0; m < 4; ++m) EPI_PIN4(g[ai][m]);
#pragma unroll
        for (int ai = 0; ai < 2; ++ai)
#pragma unroll
            for (int m = 0; m < 4; ++m)
#pragma unroll
                for (int bj = 0; bj < 2; ++bj)
                    *(u32x4*)(B.YA + o0 + (size_t)(ai * 128 + m * 16) * 1024 + bj * 128) = pack8(acc[ai][bj][m][0] * gate_dq4(g[ai][m][2 * bj]), acc[ai][bj][m][1] * gate_dq4(g[ai][m][2 * bj + 1]));
    }
};
struct EpiPoolUp {
    static constexpr bool PERM = true; static constexpr int MIDK = 0; static constexpr int SCLA = 0x7f7f7f7f;
    Bufs B;
    __device__ __forceinline__ void operator()(const f32x4 (&acc)[2][2][4][2], const pg::Unit& u, int wr, int wc, int fr, int fq) const {
        asm volatile("" : "+v"(fr), "+v"(fq));
        const size_t r0 = ((size_t)u.pm * 256 + wr * 64 + fr) * 1024 + u.pn * 256;
        const size_t o0 = r0 + wc * 32 + fq * 8;
        const unsigned char* gp = (const unsigned char*)B.SGP + r0 + wc * 64 + fq * 16;
#pragma unroll
        for (int ai = 0; ai < 2; ++ai) {
            u32x4 g[4], y[4][2];
#pragma unroll
            for (int m = 0; m < 4; ++m) { g[m] = *(const u32x4*)(gp + (size_t)(ai * 128 + m * 16) * 1024);
#pragma unroll
                for (int bj = 0; bj < 2; ++bj) y[m][bj] = *(const u32x4*)(B.YA + o0 + (size_t)(ai * 128 + m * 16) * 1024 + bj * 128); }
            asm volatile("s_waitcnt vmcnt(0)" ::: "memory");
#pragma unroll
            for (int m = 0; m < 4; ++m) { EPI_PIN4(g[m]);
#pragma unroll
                for (int bj = 0; bj < 2; ++bj) EPI_PIN4(y[m][bj]); }
#pragma unroll
            for (int m = 0; m < 4; ++m)
#pragma unroll
                for (int bj = 0; bj < 2; ++bj) {
                    f32x4 y0, y1; unpack8(y[m][bj], y0, y1);
                    *(u32x4*)(B.MX + o0 + (size_t)(ai * 128 + m * 16) * 1024 + bj * 128) = pack8(y0 + acc[ai][bj][m][0] * gate_dq4(g[m][2 * bj]), y1 + acc[ai][bj][m][1] * gate_dq4(g[m][2 * bj + 1]));
                }
        }
    }
};
struct EpiUpFused {
    static constexpr bool PERM = true; static constexpr int MIDK = 8; static constexpr int SCLA = 0x7f7f7f7f;
    Bufs B;
    __device__ __forceinline__ void mid(f32x4 (&acc)[2][2][4][2], const pg::Unit& u, int wr, int wc, int fr, int fq) const {
        asm volatile("" : "+v"(fr), "+v"(fq));
        const size_t r0 = ((size_t)u.pm * 256 + wr * 64 + fr) * 1024 + u.pn * 256 + wc * 64 + fq * 16;
        u32x4 g[2][4], p[2][4];
#pragma unroll
        for (int ai = 0; ai < 2; ++ai)
#pragma unroll
            for (int m = 0; m < 4; ++m) { g[ai][m] = *(const u32x4*)((const unsigned char*)B.SGA + r0 + (size_t)(ai * 128 + m * 16) * 1024); p[ai][m] = *(const u32x4*)((const unsigned char*)B.SGP + r0 + (size_t)(ai * 128 + m * 16) * 1024); }
        asm volatile("s_waitcnt vmcnt(0)" ::: "memory");
#pragma unroll
        for (int ai = 0; ai < 2; ++ai)
#pragma unroll
            for (int m = 0; m < 4; ++m) { EPI_PIN4(g[ai][m]); EPI_PIN4(p[ai][m]); }
#pragma unroll
        for (int ai = 0; ai < 2; ++ai)
#pragma unroll
            for (int m = 0; m < 4; ++m)
#pragma unroll
                for (int bj = 0; bj < 2; ++bj)
#pragma unroll
                    for (int n = 0; n < 2; ++n) {
                        const f32x4 gv = gate_dq4(g[ai][m][2 * bj + n]), pv = gate_dqp4(p[ai][m][2 * bj + n]);
#pragma unroll
                        for (int j = 0; j < 4; ++j) acc[ai][bj][m][n][j] *= gv[j] * __builtin_amdgcn_rcpf(pv[j]);
                    }
    }
    __device__ __forceinline__ void operator()(const f32x4 (&acc)[2][2][4][2], const pg::Unit& u, int wr, int wc, int fr, int fq) const {
        asm volatile("" : "+v"(fr), "+v"(fq));
        const size_t r0 = ((size_t)u.pm * 256 + wr * 64 + fr) * 1024 + u.pn * 256;
        const size_t o0 = r0 + wc * 32 + fq * 8;
        const unsigned char* gp = (const unsigned char*)B.SGP + r0 + wc * 64 + fq * 16;
        u32x4 g[2][4];
#pragma unroll
        for (int ai = 0; ai < 2; ++ai)
#pragma unroll
            for (int m = 0; m < 4; ++m) g[ai][m] = *(const u32x4*)(gp + (size_t)(ai * 128 + m * 16) * 1024);
        asm volatile("s_waitcnt vmcnt(0)" ::: "memory");
#pragma unroll
        for (int ai = 0; ai < 2; ++ai)
#pragma unroll
            for (int m = 0; m < 4; ++m) EPI_PIN4(g[ai][m]);
#pragma unroll
        for (int ai = 0; ai < 2; ++ai)
#pragma unroll
            for (int m = 0; m < 4; ++m)
#pragma unroll
                for (int bj = 0; bj < 2; ++bj)
                    { const f32x4 y0 = acc[ai][bj][m][0] * gate_dqp4(g[ai][m][2 * bj]) * 16.0f, y1 = acc[ai][bj][m][1] * gate_dqp4(g[ai][m][2 * bj + 1]) * 16.0f;
                      *(u32x2*)((fp8_t*)B.MX + o0 + (size_t)(ai * 128 + m * 16) * 1024 + bj * 128) = (u32x2){pk4_fp8(y0[0], y0[1], y0[2], y0[3]), pk4_fp8(y1[0], y1[1], y1[2], y1[3])}; }
    }
};
struct EpiOut {
    static constexpr bool PERM = true; static constexpr int MIDK = 0; static constexpr int SCLA = 0x7b7b7b7b;
    const bf16_t* xb; bf16_t* x2; fp8_t* h8; const float* g2; const float* ri;
    __device__ __forceinline__ void operator()(const f32x4 (&acc)[2][2][4][2], const pg::Unit& u, int wr, int wc, int fr, int fq) const {
        asm volatile("" : "+v"(fr), "+v"(fq));
        const size_t o0 = ((size_t)u.pm * 256 + wr * 64 + fr) * 1024 + u.pn * 256 + wc * 32 + fq * 8;
        f32x4 gv[2][2];
#pragma unroll
        for (int bj = 0; bj < 2; ++bj)
#pragma unroll
            for (int n = 0; n < 2; ++n) gv[bj][n] = *(const f32x4*)(g2 + u.pn * 256 + bj * 128 + wc * 32 + fq * 8 + n * 4);
        u32x4 xv[2][4][2];
        float ri8[8];
#pragma unroll
        for (int i = 0; i < 8; ++i) ri8[i] = ri[(size_t)u.pm * 256 + (i >> 2) * 128 + wr * 64 + (i & 3) * 16 + fr];
#pragma unroll
        for (int ai = 0; ai < 2; ++ai)
#pragma unroll
            for (int m = 0; m < 4; ++m)
#pragma unroll
                for (int bj = 0; bj < 2; ++bj) xv[ai][m][bj] = *(const u32x4*)(xb + o0 + (size_t)(ai * 128 + m * 16) * 1024 + bj * 128);
        asm volatile("s_waitcnt vmcnt(0)" ::: "memory");
#pragma unroll
        for (int ai = 0; ai < 2; ++ai)
#pragma unroll
            for (int m = 0; m < 4; ++m)
#pragma unroll
                for (int bj = 0; bj < 2; ++bj) EPI_PIN4(xv[ai][m][bj]);
#pragma unroll
        for (int i = 0; i < 8; ++i) asm volatile("" : "+v"(ri8[i]));
#pragma unroll
        for (int ai = 0; ai < 2; ++ai)
#pragma unroll
            for (int m = 0; m < 4; ++m)
#pragma unroll
                for (int bj = 0; bj < 2; ++bj) {
                    f32x4 x0, x1; unpack8(xv[ai][m][bj], x0, x1);
                    const f32x4 v0 = x0 * ri8[ai * 4 + m] + acc[ai][bj][m][0], v1 = x1 * ri8[ai * 4 + m] + acc[ai][bj][m][1];
                    const size_t o = o0 + (size_t)(ai * 128 + m * 16) * 1024 + bj * 128;
                    *(u32x4*)(x2 + o) = pack8(v0, v1);
                    const f32x4 h0 = v0 * gv[bj][0], h1 = v1 * gv[bj][1];
                    *(u32x2*)(h8 + o) = (u32x2){pk4_fp8(h0[0], h0[1], h0[2], h0[3]), pk4_fp8(h1[0], h1[1], h1[2], h1[3])};
                }
    }
};
struct EpiGateUp {
    static constexpr bool PERM = true; static constexpr int MIDK = 0; static constexpr int SCLA = 0x7f7f7f7f;
    fp8_t* ACT; const float* bias; const float* LR;
    __device__ __forceinline__ void operator()(const f32x4 (&acc)[2][2][4][2], const pg::Unit& u, int wr, int wc, int fr, int fq) const {
        asm volatile("" : "+v"(fr), "+v"(fq));
        const int ac0 = u.pn * 128 + wc * 32 + fq * 8;
        const float* bp = bias + (size_t)u.e * F2 + 2 * ac0;
        f32x4 bq[4];
#pragma unroll
        for (int j = 0; j < 4; ++j) bq[j] = *(const f32x4*)(bp + 4 * j);
        float rs8[8];
#pragma unroll
        for (int i = 0; i < 8; ++i) { const int rt = (i >> 2) * 128 + wr * 64 + (i & 3) * 16 + fr; rs8[i] = LR[u.lpos + (rt < u.nrows ? rt : 0)]; }
        asm volatile("s_waitcnt vmcnt(0)" ::: "memory");
#pragma unroll
        for (int i = 0; i < 8; ++i) asm volatile("" : "+v"(rs8[i]));
        f32x2 bgp[4], bup[4];
#pragma unroll
        for (int k = 0; k < 4; ++k) { bgp[k] = (f32x2){bq[k][0], bq[k][2]}; bup[k] = (f32x2){bq[k][1], bq[k][3]}; asm volatile("" : "+v"(bgp[k]), "+v"(bup[k])); }
#pragma unroll
        for (int ai = 0; ai < 2; ++ai)
#pragma unroll
            for (int m = 0; m < 4; ++m) {
                const int rt = ai * 128 + wr * 64 + m * 16 + fr;
                if (rt < u.nrows) {
                    const float rs = rs8[ai * 4 + m];
                    f32x4 o[2];
#pragma unroll
                    for (int n = 0; n < 2; ++n)
#pragma unroll
                        for (int jp = 0; jp < 2; ++jp) {
                            const int c = 4 * n + 2 * jp;
                            const f32x2 ag = {acc[ai][0][m][n][2 * jp], acc[ai][0][m][n][2 * jp + 1]}, au = {acc[ai][1][m][n][2 * jp], acc[ai][1][m][n][2 * jp + 1]};
                            const f32x2 bg = bgp[c >> 1], bu = bup[c >> 1];
                            f32x2 g = ag * rs + bg, uu = au * rs + bu;
                            g.x = __builtin_amdgcn_fmed3f(g.x, -24.0f, 7.0f); g.y = __builtin_amdgcn_fmed3f(g.y, -24.0f, 7.0f);
                            uu.x = __builtin_amdgcn_fmed3f(uu.x, -7.0f, 7.0f); uu.y = __builtin_amdgcn_fmed3f(uu.y, -7.0f, 7.0f);
                            const f32x2 t = g * (-1.702f * 1.4426950408889634f);
                            f32x2 e; e.x = __builtin_amdgcn_exp2f(t.x); e.y = __builtin_amdgcn_exp2f(t.y);
                            const f32x2 d = e + 1.0f;
                            const float rp = __builtin_amdgcn_rcpf(d.x * d.y);
                            f32x2 sg; sg.x = rp * d.y; sg.y = rp * d.x;
                            const f32x2 gs = g * sg, r2 = uu * gs + gs;
                            o[n][2 * jp] = r2.x; o[n][2 * jp + 1] = r2.y;
                        }
                    *(u32x2*)(ACT + ((size_t)u.pm * 256 + rt) * 1024 + ac0) = (u32x2){pk4_fp8(o[0][0], o[0][1], o[0][2], o[0][3]), pk4_fp8(o[1][0], o[1][1], o[1][2], o[1][3])};
                }
            }
    }
};
struct EpiDown {
    static constexpr bool PERM = true; static constexpr int MIDK = 0; static constexpr int SCLA = 0x7f7f7f7f;
    fp8_t* Y4; const float* bias; const float* gates; const int* LI;
    __device__ __forceinline__ void operator()(const f32x4 (&acc)[2][2][4][2], const pg::Unit& u, int wr, int wc, int fr, int fq) const {
        asm volatile("" : "+v"(fr), "+v"(fq));
        f32x4 bq[2][2];
#pragma unroll
        for (int bj = 0; bj < 2; ++bj) { const float* bp = bias + (size_t)u.e * 1024 + u.pn * 256 + bj * 128 + wc * 32 + fq * 8; bq[bj][0] = *(const f32x4*)bp; bq[bj][1] = *(const f32x4*)(bp + 4); }
        int a8[8]; float g8[8];
#pragma unroll
        for (int i = 0; i < 8; ++i) { const int rt = (i >> 2) * 128 + wr * 64 + (i & 3) * 16 + fr; const int q = u.lpos + (rt < u.nrows ? rt : 0); a8[i] = LI[q]; g8[i] = gates[q]; }
        asm volatile("s_waitcnt vmcnt(0)" ::: "memory");
#pragma unroll
        for (int i = 0; i < 8; ++i) asm volatile("" : "+v"(a8[i]), "+v"(g8[i]));
#pragma unroll
        for (int bj = 0; bj < 2; ++bj) asm volatile("" : "+v"(bq[bj][0]), "+v"(bq[bj][1]));
#pragma unroll
        for (int ai = 0; ai < 2; ++ai)
#pragma unroll
            for (int m = 0; m < 4; ++m) {
                const int rt = ai * 128 + wr * 64 + m * 16 + fr;
                if (rt < u.nrows) {
                    const int a = a8[ai * 4 + m]; const float gt = g8[ai * 4 + m] * 8.0f;
#pragma unroll
                    for (int bj = 0; bj < 2; ++bj) {
                        const f32x4 y0 = (acc[ai][bj][m][0] + bq[bj][0]) * gt, y1 = (acc[ai][bj][m][1] + bq[bj][1]) * gt;
                        *(u32x2*)(Y4 + (size_t)a * 1024 + u.pn * 256 + bj * 128 + wc * 32 + fq * 8) = (u32x2){pk4_fp8(y0[0], y0[1], y0[2], y0[3]), pk4_fp8(y1[0], y1[1], y1[2], y1[3])};
                    }
                }
            }
    }
};

struct MoeOrder {
    const LAS int* tab; int NT, G, c, total; const char* Abase; const char* Bbase; size_t bexp; const int* list; bool dense_a;
    __device__ bool next(int i, pg::Unit& u) const {
        const long L = (long)i * G + c; if (L >= total) return false;
        int e = 0;
        for (int j = 1; j < NE; ++j) e += (tab[j] <= (int)L) ? 1 : 0;
        e = __builtin_amdgcn_readfirstlane(e);
        const int l = (int)L - __builtin_amdgcn_readfirstlane(tab[e]), rt = l / NT, pn = l - rt * NT;
        const int cnt = __builtin_amdgcn_readfirstlane(tab[64 + e]), ro = __builtin_amdgcn_readfirstlane(tab[128 + e]);
        u.e = e; u.pn = pn; u.pm = ro + rt; u.nrows = (cnt - rt * 256) < 256 ? (cnt - rt * 256) : 256;
        u.rl = list + (size_t)e * T + rt * 256; u.lpos = e * T + rt * 256;
        u.a = dense_a ? Abase + (size_t)(ro + rt) * 256 * 1024 : Abase;
        u.b = Bbase + (size_t)e * bexp + (size_t)pn * 256 * 1024;
        return true;
    }
};

__device__ __forceinline__ int inproj_src(int n) {
    if (n < 512) return C_Q + n;
    if (n < 576) return C_K + (n - 512);
    if (n < 640) return C_V + (n - 576);
    if (n < 672) return C_IK + (n - 640);
    if (n < 680) return C_IW + (n - 672);
    if (n < 768) return -1;
    if (n < 1024) return C_IQ + (n - 768);
    if (n < 1536) return C_U + (n - 1024);
    if (n < 2560) return C_GA + (n - 1536);
    return C_GP + (n - 2560);
}
template <int MODE> __device__ __forceinline__ void transpose_item(const float* W, int K, int N, bf16_t* WT, LAS float* scr, int item, int nblk, int lane, int ldw = 0, const float* ks = nullptr) {
    if (ldw == 0) ldw = K;
    const int kb = item / nblk, nb = item % nblk, k0 = 64 * kb, n0 = 32 * nb;
    const int nd = n0 + (lane & 31);
    int sc;
    if (MODE == 0) sc = nd; else if (MODE == 1) sc = inproj_src(nd); else { const int p = nd >> 8, bj = (nd >> 7) & 1, i = nd & 127; sc = 2 * (128 * p + i) + bj; }
#pragma unroll 8
    for (int i = 0; i < 32; ++i) { const int kk = 2 * i + (lane >> 5); float w = (sc >= 0) ? W[(size_t)(k0 + kk) * N + sc] : 0.f; if (MODE == 1) w *= ks[k0 + kk]; scr[kk * 33 + (lane & 31)] = w; }
    asm volatile("s_waitcnt lgkmcnt(0)" ::: "memory");
    const int c = lane & 7;
#pragma unroll
    for (int j = 0; j < 4; ++j) { const int n = (lane >> 3) + 8 * j; const LAS float* s = scr + (8 * c) * 33 + n;
        u32x4 o; o.x = pk2(s[0 * 33], s[1 * 33]); o.y = pk2(s[2 * 33], s[3 * 33]); o.z = pk2(s[4 * 33], s[5 * 33]); o.w = pk2(s[6 * 33], s[7 * 33]);
        *(u32x4*)(WT + (size_t)(n0 + n) * ldw + k0 + 8 * c) = o; }
    asm volatile("s_waitcnt lgkmcnt(0)" ::: "memory");
}

template <int MODE> __device__ __forceinline__ void transpose_item_f8(const float* W, int K, int N, fp8_t* WT, LAS float* scr, int item, int nblk, int lane, const float* ks = nullptr) {
    const int kb = item / nblk, nb = item % nblk, k0 = 64 * kb, n0 = 32 * nb;
    const int nd = n0 + (lane & 31);
    int sc;
    if (MODE == 0) sc = nd; else if (MODE == 1) sc = inproj_src(1536 + nd); else { const int p = nd >> 8, bj = (nd >> 7) & 1, i = nd & 127; sc = 2 * (128 * p + i) + bj; }
    float v[32];
#pragma unroll
    for (int i = 0; i < 32; ++i) v[i] = W[(size_t)(k0 + 2 * i + (lane >> 5)) * N + sc];
#pragma unroll
    for (int i = 0; i < 32; ++i) scr[(2 * i + (lane >> 5)) * 33 + (lane & 31)] = v[i] * (MODE == 1 ? 64.0f * ks[k0 + 2 * i + (lane >> 5)] : 64.0f);
    asm volatile("s_waitcnt lgkmcnt(0)" ::: "memory");
    const int c = lane & 3;
#pragma unroll
    for (int j = 0; j < 2; ++j) { const int n = (lane >> 2) + 16 * j; const LAS float* s = scr + (16 * c) * 33 + n;
        u32x4 o; o.x = pk4_fp8(s[0 * 33], s[1 * 33], s[2 * 33], s[3 * 33]); o.y = pk4_fp8(s[4 * 33], s[5 * 33], s[6 * 33], s[7 * 33]);
        o.z = pk4_fp8(s[8 * 33], s[9 * 33], s[10 * 33], s[11 * 33]); o.w = pk4_fp8(s[12 * 33], s[13 * 33], s[14 * 33], s[15 * 33]);
        *(u32x4*)(WT + (size_t)(n0 + n) * K + k0 + 16 * c) = o; }
    asm volatile("s_waitcnt lgkmcnt(0)" ::: "memory");
}

template <int MODE> __device__ __forceinline__ void transpose_tile_f8(const float* W, int K, int N, fp8_t* WT, LAS unsigned char* lds, int kt, int nt, int ns0 = -1, const float* ks = nullptr) {
    const int tid = threadIdx.x;
    LAS float* s = (LAS float*)lds;
    const int k0 = 128 * kt, n0 = 256 * nt, nsrc = ns0 >= 0 ? ns0 : n0;
    f32x4 v[16];
#pragma unroll
    for (int i = 0; i < 16; ++i) v[i] = *(const f32x4*)(W + (size_t)(k0 + 8 * i + (tid >> 6)) * N + nsrc + 4 * (tid & 63));
    if (ks) {
#pragma unroll
        for (int i = 0; i < 16; ++i) v[i] *= ks[k0 + 8 * i + (tid >> 6)];
    }
#pragma unroll
    for (int i = 0; i < 16; ++i) *(LAS f32x4*)(s + (8 * i + (tid >> 6)) * 260 + 4 * (tid & 63)) = v[i];
    __syncthreads();
    const int r = tid & 255, kh = tid >> 8;
    const int sc = MODE == 0 ? r : 2 * (r & 127) + (r >> 7);
    const LAS float* sp = s + (64 * kh) * 260 + sc;
#pragma unroll
    for (int j = 0; j < 4; ++j) {
        float q[16];
#pragma unroll
        for (int e = 0; e < 16; ++e) q[e] = sp[(16 * j + e) * 260] * 64.0f;
        u32x4 o; o.x = pk4_fp8(q[0], q[1], q[2], q[3]); o.y = pk4_fp8(q[4], q[5], q[6], q[7]); o.z = pk4_fp8(q[8], q[9], q[10], q[11]); o.w = pk4_fp8(q[12], q[13], q[14], q[15]);
        *(u32x4*)(WT + (size_t)(n0 + r) * K + k0 + 64 * kh + 16 * j) = o;
    }
    __syncthreads();
}

struct Args {
    const float* in[16]; float* out; unsigned char* ws; int ph_lo, ph_hi;
};

constexpr int LDS_XB = 151552 - 64;
constexpr int CW_BAR = 1024;
constexpr int LDS_TAB = pg::STAGE_BYTES;
constexpr int LDS_BYTES = 151552;

__device__ __forceinline__ void moe_tables(LAS int* tab, const int* cnt_g, int NT) {
    if (threadIdx.x < 64) {
        const int lane = threadIdx.x;
        const int c = lane < NE ? __hip_atomic_load(cnt_g + lane, __ATOMIC_RELAXED, __HIP_MEMORY_SCOPE_AGENT) : 0;
        const int rt = (c + 255) >> 8;
        int pre = rt;
#pragma unroll
        for (int o = 1; o < 64; o <<= 1) { const int v = __shfl_up(pre, o); if (lane >= o) pre += v; }
        const int excl = pre - rt;
        if (lane < NE) { tab[lane] = excl * NT; tab[64 + lane] = c; tab[128 + lane] = excl; }
        if (lane == NE) { tab[NE] = excl * NT; tab[128 + NE] = excl; }
    }
    __syncthreads();
}


typedef float f32x16 __attribute__((ext_vector_type(16)));
__device__ __forceinline__ int wave_total_le32(int c) {
    int tot = 0;
#pragma unroll
    for (int b = 0; b < 6; ++b) tot += __builtin_popcountll(__ballot((c >> b) & 1)) << b;
    return tot;
}
__device__ __forceinline__ unsigned ord_key(float f) { const unsigned u = __float_as_uint(f); return u ^ ((unsigned)((int)u >> 31) | 0x80000000u); }
template <int CTRL> __device__ __forceinline__ float dppf(float v) { return __int_as_float(__builtin_amdgcn_update_dpp(0, __float_as_int(v), CTRL, 0xf, 0xf, true)); }
__device__ __forceinline__ float wave_max_u(float v) {
    v = fmaxf(v, dppf<0xB1>(v)); v = fmaxf(v, dppf<0x4E>(v)); v = fmaxf(v, dppf<0x141>(v)); v = fmaxf(v, dppf<0x140>(v));
    const int b = __float_as_int(v);
    return fmaxf(fmaxf(__int_as_float(__builtin_amdgcn_readlane(b, 0)), __int_as_float(__builtin_amdgcn_readlane(b, 16))), fmaxf(__int_as_float(__builtin_amdgcn_readlane(b, 32)), __int_as_float(__builtin_amdgcn_readlane(b, 48))));
}
__device__ __forceinline__ int wave_incl_scan(int v) {
    v += __builtin_amdgcn_update_dpp(0, v, 0x111, 0xf, 0xf, false);
    v += __builtin_amdgcn_update_dpp(0, v, 0x112, 0xf, 0xf, false);
    v += __builtin_amdgcn_update_dpp(0, v, 0x114, 0xf, 0xf, false);
    v += __builtin_amdgcn_update_dpp(0, v, 0x118, 0xf, 0xf, false);
    v += __builtin_amdgcn_update_dpp(0, v, 0x142, 0xa, 0xf, false);
    v += __builtin_amdgcn_update_dpp(0, v, 0x143, 0xc, 0xf, false);
    return v;
}
template <int KPL> __device__ __forceinline__ unsigned select_word(const float (&x)[KPL], unsigned vm, int lane, LAS int* hist, LAS float* cval, const LAS float* srow, bool& pick, int& cid) {
    unsigned active = vm, sel = 0u; int need = NKEYS; pick = false; cid = 0;
    for (;;) {
        float mnn = -__builtin_inff(), mxx = -__builtin_inff();
#pragma unroll
        for (int i = 0; i < KPL; ++i) { const bool a = (active >> i) & 1u; mnn = a ? fmaxf(mnn, -x[i]) : mnn; mxx = a ? fmaxf(mxx, x[i]) : mxx; }
        const float mn = -wave_max_u(mnn), mx = wave_max_u(mxx);
        const float scale = 256.0f / (mx - mn);
        if (!(scale < 1.0e37f)) {
            if (mn == mx) {
                const int c = __builtin_popcount(active); const int incl = wave_incl_scan(c);
                int allow = need - (incl - c);
#pragma unroll
                for (int i = 0; i < KPL; ++i) { const bool a = (active >> i) & 1u; if (a && allow > 0) sel |= 1u << i; if (a) --allow; }
                return sel;
            }
            const unsigned kmax = ord_key(mx); const unsigned span = kmax - ord_key(mn); const int nbits = 32 - __builtin_clz(span); const int shift = nbits > 6 ? nbits - 6 : 0;
            *(LAS f32x4*)(hist + 4 * lane) = (f32x4){0.f, 0.f, 0.f, 0.f};
#pragma unroll
            for (int i = 0; i < KPL; ++i) { const int b = (int)((kmax - ord_key(x[i])) >> shift); __hip_atomic_fetch_add(&hist[((active >> i) & 1u) ? b : 255], (int)((active >> i) & 1u), __ATOMIC_RELAXED, __HIP_MEMORY_SCOPE_WAVEFRONT); }
            const int h = hist[lane];
            const int incl = wave_incl_scan(h);
            const int Ls = __builtin_ctzll(__ballot(incl >= need));
            const int above = __builtin_amdgcn_readlane(incl, Ls) - __builtin_amdgcn_readlane(h, Ls), cnt = __builtin_amdgcn_readlane(h, Ls);
            unsigned na = 0u;
#pragma unroll
            for (int i = 0; i < KPL; ++i) { const int b = (int)((kmax - ord_key(x[i])) >> shift); const unsigned bit = active & (1u << i); sel |= (b < Ls) ? bit : 0u; na |= (b == Ls) ? bit : 0u; }
            active = na; need -= above;
            if (cnt <= 64) break;
            continue;
        }
        *(LAS f32x4*)(hist + 4 * lane) = (f32x4){0.f, 0.f, 0.f, 0.f};
#pragma unroll
        for (int i = 0; i < KPL; ++i) {
            int b = (int)((mx - x[i]) * scale); b = b < 0 ? 0 : (b > 255 ? 255 : b);
            __hip_atomic_fetch_add(&hist[b], (int)((active >> i) & 1u), __ATOMIC_RELAXED, __HIP_MEMORY_SCOPE_WAVEFRONT);
        }
        const int h0 = hist[4 * lane], h1 = hist[4 * lane + 1], h2 = hist[4 * lane + 2], h3 = hist[4 * lane + 3];
        const int L = h0 + h1 + h2 + h3, incl = wave_incl_scan(L);
        const int Ls = __builtin_ctzll(__ballot(incl >= need));
        int c = __builtin_amdgcn_readlane(incl, Ls) - __builtin_amdgcn_readlane(L, Ls);
        const int g0 = __builtin_amdgcn_readlane(h0, Ls), g1 = __builtin_amdgcn_readlane(h1, Ls), g2 = __builtin_amdgcn_readlane(h2, Ls), g3 = __builtin_amdgcn_readlane(h3, Ls);
        int Bs = 4 * Ls, cnt = g0;
        if (c + g0 < need) { c += g0; Bs += 1; cnt = g1; if (c + g1 < need) { c += g1; Bs += 1; cnt = g2; if (c + g2 < need) { c += g2; Bs += 1; cnt = g3; } } }
        const float fB = (float)Bs, fB1 = (float)(Bs + 1);
        unsigned na = 0u;
#pragma unroll
        for (int i = 0; i < KPL; ++i) {
            const float q = (mx - x[i]) * scale; const unsigned bit = active & (1u << i);
            const bool lt = q < fB, inb = (q >= fB) && (q < fB1 || Bs == 255);
            sel |= lt ? bit : 0u; na |= inb ? bit : 0u;
        }
        active = na; need -= c;
        if (cnt <= 64) break;
    }
    LAS f32x2* cv2 = (LAS f32x2*)cval;
    const int cmine = __builtin_popcount(active);
    int pos = wave_incl_scan(cmine) - cmine;
    const int base = __builtin_amdgcn_readlane(pos, 63) + __builtin_amdgcn_readlane(cmine, 63);
    {
        unsigned rem = active;
        while (__ballot(rem != 0u) != 0ull) {
            if (rem != 0u) { const int i = __builtin_ctz(rem); rem &= rem - 1u; cv2[pos++] = (f32x2){srow[KPL * lane + i], __int_as_float(KPL * lane + i)}; }
        }
    }
    const int m = base, me = lane < m ? lane : 0;
    const f32x2 mine = cv2[me]; const float v = mine.x; const int id = __float_as_int(mine.y);
    int rank = 0;
    for (int u = 0; u < m; ++u) { const f32x2 o = cv2[u]; const int iu = __float_as_int(o.y); rank += (o.x > v || (o.x == v && iu < id)) ? 1 : 0; }
    pick = lane < m && rank < need; cid = id;
    return sel;
}
template <int KPL> __device__ __forceinline__ void select_pair(const LAS float* sc, unsigned* MASK, int row0, int t0, int wid, int lane, LAS int* hs, LAS float* cv) {
#pragma unroll 1
    for (int qq = 0; qq < 2; ++qq) {
        const int ql = 2 * wid + qq, t = t0 + ql, nk = t + 1;
        const int kbase = KPL * lane;
        const int nb = t - kbase + 1;
        const unsigned full = KPL == 32 ? 0xffffffffu : ((1u << (KPL & 31)) - 1u);
        const unsigned vm = nb >= KPL ? full : (nb <= 0 ? 0u : ((1u << nb) - 1u));
        unsigned w; bool pick = false; int cid = 0;
        if (nk <= NKEYS) w = vm;
        else {
            float xv[KPL];
#pragma unroll
            for (int j = 0; j < KPL / 4; ++j) {
                const f32x4 v = *(const LAS f32x4*)(sc + ql * 2048 + kbase + 4 * j);
                xv[4 * j] = v[0]; xv[4 * j + 1] = v[1]; xv[4 * j + 2] = v[2]; xv[4 * j + 3] = v[3];
            }
            w = select_word<KPL>(xv, vm, lane, hs, cv, sc + ql * 2048, pick, cid);
        }
        LAS unsigned* wa = (LAS unsigned*)cv;
        wa[lane] = 0u; if (lane == 0) wa[64] = 0u;
        if (pick) __hip_atomic_fetch_or(&wa[cid >> 5], 1u << (cid & 31), __ATOMIC_RELAXED, __HIP_MEMORY_SCOPE_WAVEFRONT);
        const int off = KPL * lane, sh = off & 31, wi = off >> 5;
        __hip_atomic_fetch_or(&wa[wi], w << sh, __ATOMIC_RELAXED, __HIP_MEMORY_SCOPE_WAVEFRONT);
        if (KPL < 32 && sh + KPL > 32) __hip_atomic_fetch_or(&wa[wi + 1], w >> (32 - sh), __ATOMIC_RELAXED, __HIP_MEMORY_SCOPE_WAVEFRONT);
        asm volatile("s_waitcnt lgkmcnt(0)" ::: "memory");
        MASK[(size_t)(row0 + ql) * 64 + lane] = wa[lane];
    }
}
__device__ __forceinline__ void dsa_mask_phase(LAS unsigned char* lds, const Bufs& B, unsigned* MASK, int G, int vcu) {
    LAS float* sc = (LAS float*)lds;
    const int tid = threadIdx.x, lane = tid & 63, wid = __builtin_amdgcn_readfirstlane(tid >> 6), r32 = lane & 31, hi = lane >> 5;
    const int npairs = NB * 64;
    for (int pr = vcu; pr < npairs; pr += G) {
        for (int s2 = 0; s2 < 2; ++s2) {
            const int b = pr >> 6, kk = ((pr & 63) + 16 * (pr / G)) & 63, ti = s2 ? 127 - kk : kk;
            const int t0 = ti * 16, row0 = b * S + t0, nkb = (t0 + 16 + 31) >> 5;
            bf16x8 af[4][2];
            {
                const int a = r32 >> 4, bb = (r32 >> 3) & 1, c = (r32 >> 2) & 1, d = r32 & 3;
                const int tokl = 2 * c + a, head = 4 * bb + d;
#pragma unroll
                for (int rb = 0; rb < 4; ++rb)
#pragma unroll
                    for (int ks = 0; ks < 2; ++ks) af[rb][ks] = *(const bf16x8*)(B.IQ + (size_t)(row0 + 4 * rb + tokl) * 256 + head * 32 + 16 * ks + 8 * hi);
            }
            LAS float* wl = (LAS float*)(lds + 147456);
            __syncthreads();
            if (tid < 128) wl[tid] = B.IW[(size_t)row0 * 8 + tid];
            __syncthreads();
            for (int kb = wid; kb < nkb; kb += 8) {
                const int key = 32 * kb + r32;
                const bf16x8 bf0 = *(const bf16x8*)(B.IK + (size_t)(b * S + key) * 32 + 8 * hi);
                const bf16x8 bf1 = *(const bf16x8*)(B.IK + (size_t)(b * S + key) * 32 + 16 + 8 * hi);
#pragma unroll
                for (int rb = 0; rb < 4; ++rb) {
                    f32x16 acc = {};
                    acc = __builtin_amdgcn_mfma_f32_32x32x16_bf16(af[rb][0], bf0, acc, 0, 0, 0);
                    acc = __builtin_amdgcn_mfma_f32_32x32x16_bf16(af[rb][1], bf1, acc, 0, 0, 0);
#pragma unroll
                    for (int a = 0; a < 2; ++a) {
                        float sv = 0.f;
#pragma unroll
                        for (int bb = 0; bb < 2; ++bb)
                        { const f32x4 wv = *(const LAS f32x4*)(wl + (4 * rb + 2 * hi + a) * 8 + 4 * bb);
#pragma unroll
                            for (int d = 0; d < 4; ++d) sv = fmaf(wv[d], fmaxf(acc[8 * a + 4 * bb + d], 0.f), sv); }
                        sc[(4 * rb + 2 * hi + a) * 2048 + key] = sv;
                    }
                }
            }
            __syncthreads();
            {
                LAS int* hs = (LAS int*)(lds + 131072 + wid * 2048); LAS float* cv = (LAS float*)(lds + 131072 + wid * 2048 + 1024);
                const int nkmax = t0 + 16;
                switch ((nkmax + 255) >> 8) {
                    case 0: case 1: case 2: select_pair<8>(sc, MASK, row0, t0, wid, lane, hs, cv); break;
                    case 3: select_pair<12>(sc, MASK, row0, t0, wid, lane, hs, cv); break;
                    case 4: select_pair<16>(sc, MASK, row0, t0, wid, lane, hs, cv); break;
                    case 5: select_pair<20>(sc, MASK, row0, t0, wid, lane, hs, cv); break;
                    case 6: select_pair<24>(sc, MASK, row0, t0, wid, lane, hs, cv); break;
                    case 7: select_pair<28>(sc, MASK, row0, t0, wid, lane, hs, cv); break;
                    default: select_pair<32>(sc, MASK, row0, t0, wid, lane, hs, cv); break;
                }
            }
        }
    }
    __syncthreads();
}

namespace att {
typedef short s16x4 __attribute__((ext_vector_type(4)));
typedef short v4i16_t __attribute__((ext_vector_type(4)));
constexpr int NW = 8, QBLK = 32, QB = QBLK * NW, KVBLK = 64, NQB = S / QB, DMQ = 512, DMK = 64, DMO = 1024;
constexpr float C2 = 0.125f * 1.4426950408889634f;
constexpr float NEGM = -1.0e30f, MFLOOR = -1.0e5f;
constexpr int THR = 8;
constexpr int SLOTB = 8192, LDS_K = 0, LDS_V = 3 * SLOTB, LDS_WS = 6 * SLOTB, LDS_OST = LDS_WS + NW * 256, LDS_MK = LDS_OST + NW * 4096, LDS_END = LDS_MK + 32 * 2048;
#define SBAR() __builtin_amdgcn_sched_barrier(0)
#define PIN(x) asm volatile("" : "+v"(x))
#define MFMA32(a, b, c) __builtin_amdgcn_mfma_f32_32x32x16_bf16(a, b, c, 0, 0, 0)
#define WAIT_BAR(N) asm volatile("s_waitcnt vmcnt(" #N ") lgkmcnt(0)\n\ts_barrier" ::: "memory")
__device__ __forceinline__ int crow(int r, int hi) { return (r & 3) + 8 * (r >> 2) + 4 * hi; }
__device__ __forceinline__ unsigned cvtpk(float lo, float hi) { unsigned r; asm("v_cvt_pk_bf16_f32 %0, %1, %2" : "=v"(r) : "v"(lo), "v"(hi)); return r; }
__device__ __forceinline__ void glds16(const void* g, unsigned lds_base) {
    unsigned sv; asm volatile("s_mov_b32 %0, m0\n\ts_mov_b32 m0, %2\n\ts_nop 0\n\tglobal_load_lds_dwordx4 %1, off\n\ts_mov_b32 m0, %0" : "=&s"(sv) : "v"(g), "s"(lds_base) : "memory"); }
typedef LAS const char* lds_cptr;
__device__ __forceinline__ void kload2(bf16x8* kf, lds_cptr kp, int d0) { kf[2 * d0] = *(const LAS bf16x8*)(kp + d0 * 2048); kf[2 * d0 + 1] = *(const LAS bf16x8*)(kp + d0 * 2048 + 512); }
__device__ __forceinline__ s16x4 vtr(lds_cptr p) { return __builtin_bit_cast(s16x4, __builtin_amdgcn_ds_read_tr16_b64_v4i16((LAS v4i16_t*)p)); }
#define MX3(a, b, c) __builtin_fmaxf(__builtin_fmaxf((a), (b)), (c))
__device__ __forceinline__ float rowmax(const f32x16& p0, const f32x16& p1) {
    float a = MX3(p0[0], p0[1], p1[0]), b = MX3(p0[2], p0[3], p1[1]); a = MX3(a, p1[2], p1[3]);
#pragma unroll
    for (int r = 4; r < 16; r += 4) { a = MX3(a, p0[r], p0[r + 1]); b = MX3(b, p0[r + 2], p0[r + 3]); a = MX3(a, p1[r], p1[r + 1]); b = MX3(b, p1[r + 2], p1[r + 3]); }
    float m = __builtin_fmaxf(a, b); auto rr = __builtin_amdgcn_permlane32_swap(__float_as_uint(m), __float_as_uint(m), false, false);
    return __builtin_fmaxf(__uint_as_float(rr[0]), __uint_as_float(rr[1])); }
__device__ __forceinline__ void amask(f32x16& p0, f32x16& p1, unsigned w0, unsigned w1, int hi) {
    const unsigned a = w0 >> (4 * hi), b = w1 >> (4 * hi);
#pragma unroll
    for (int r = 0; r < 16; ++r) { const int bit = (r & 3) + 8 * (r >> 2); if (!((a >> bit) & 1u)) p0[r] = NEGM; if (!((b >> bit) & 1u)) p1[r] = NEGM; } }

__device__ __forceinline__ void attn_unit(int b, int qi, const bf16_t* Q, const bf16_t* __restrict__ K, const bf16_t* __restrict__ V, const unsigned* __restrict__ MASK, bf16_t* O, LAS char* lds) {
    const int tid = threadIdx.x, lane = tid & 63, r32 = lane & 31, hi = lane >> 5; const int wid = __builtin_amdgcn_readfirstlane(tid >> 6);
    const long rowbase = (long)b * S; const int q0 = qi * QBLK; int NT = (q0 + QBLK + KVBLK - 1) / KVBLK; NT = (NT + 1) & ~1; NT = NT < 4 ? 4 : NT;
    const bf16_t* Qw = Q + (rowbase + q0) * DMQ + wid * 64;
    const unsigned lds0 = (unsigned)(uintptr_t)lds; LAS float* wsf = (LAS float*)(lds + LDS_WS) + wid * 64;
    {
        const int mq = tid >> 4, tl = 2 * (tid & 15);
        const u32x4 mv = *(const u32x4*)(MASK + (size_t)(rowbase + q0 + mq) * 64 + 2 * tl);
        *(LAS u32x2*)(lds + LDS_MK + tl * 256 + mq * 8) = (u32x2){mv.x, mv.y};
        *(LAS u32x2*)(lds + LDS_MK + (tl + 1) * 256 + mq * 8) = (u32x2){mv.z, mv.w};
    }
    const LAS char* mkp = lds + LDS_MK + r32 * 8;
    const bf16_t* ksrc = K + rowbase * DMK + (long)lane * DMK + wid * 8;
    const bf16_t* vsrc = V + rowbase * DMK + (long)(16 * (wid & 3) + (lane >> 2)) * DMK + (wid >> 2) * 32 + (lane & 3) * 8;
    const unsigned kdst = lds0 + LDS_K + wid * 1024, vdst = lds0 + LDS_V + wid * 1024;
#define DMA_K(t, slot) glds16(ksrc + (long)(t) * KVBLK * DMK, (unsigned)__builtin_amdgcn_readfirstlane(kdst + (slot)))
#define DMA_V(t, slot) glds16(vsrc + (long)(t) * KVBLK * DMK, (unsigned)__builtin_amdgcn_readfirstlane(vdst + (slot)))
    const lds_cptr vp0 = (lds_cptr)lds + LDS_V + ((lane >> 4) & 1) * 32 + (lane & 3) * 8 + (4 * hi + ((lane & 15) >> 2)) * 64;
    const lds_cptr kp0 = (lds_cptr)lds + LDS_K + hi * 1024 + r32 * 16;
    asm volatile("s_waitcnt vmcnt(0)" ::: "memory");
    DMA_K(0, 0); DMA_V(0, 0); DMA_K(1, SLOTB);
    bf16x8 qr[4];
#pragma unroll
    for (int d0 = 0; d0 < 4; ++d0) qr[d0] = *reinterpret_cast<const bf16x8*>(&Qw[(long)r32 * DMQ + d0 * 16 + hi * 8]);
    float mhat = 0.f, l_reg = 0.f; f32x16 o[2]; o[0] = f32x16{}; o[1] = f32x16{};
    const f32x16 zero16 = f32x16{};
    bool resc = false;
    f32x16 pA0, pA1, pB0, pB1; bf16x8 kf[8]; s16x4 vlo[8], vhi[8]; u32x4 pw0, pw1, pw2, pw3;
    int sl_prev = 0, sl_cur = 0, sl_next = SLOTB;
#define ROT() do { sl_prev = sl_cur; sl_cur = sl_next; sl_next = (sl_next == 2 * SLOTB) ? 0 : sl_next + SLOTB; } while (0)
#define EX(v) __builtin_amdgcn_exp2f(__builtin_fmaf((v), C2, nmh))
#define RESC() do { if (resc) { _Pragma("unroll") for (int d_ = 0; d_ < 2; ++d_) _Pragma("unroll") for (int r = 0; r < 16; ++r) o[d_][r] *= wsf[crow(r, hi)]; } } while (0)
    DMA_K(2, 2 * SLOTB);
    WAIT_BAR(3);
    _Pragma("unroll") for (int d0 = 0; d0 < 4; ++d0) kload2(kf, kp0, d0);
    pA0 = MFMA32(kf[0], qr[0], zero16); pA1 = MFMA32(kf[1], qr[0], zero16); pA0 = MFMA32(kf[2], qr[1], pA0); pA1 = MFMA32(kf[3], qr[1], pA1);
    pA0 = MFMA32(kf[4], qr[2], pA0); pA1 = MFMA32(kf[5], qr[2], pA1); pA0 = MFMA32(kf[6], qr[3], pA0); pA1 = MFMA32(kf[7], qr[3], pA1);
    { const u32x2 mw = *(const LAS u32x2*)(mkp); amask(pA0, pA1, mw.x, mw.y, hi); }
    { const float rm = rowmax(pA0, pA1); mhat = __builtin_fmaxf(rm * C2, MFLOOR); const float nmh = -mhat;
#pragma unroll
      for (int r = 0; r < 16; ++r) { pA0[r] = EX(pA0[r]); pA1[r] = EX(pA1[r]); } }
    WAIT_BAR(0);
    DMA_K(3, 0); DMA_V(1, SLOTB); ROT();
    _Pragma("unroll") for (int d0 = 0; d0 < 4; ++d0) kload2(kf, kp0 + sl_cur, d0);
    WAIT_BAR(2);
#define PKW(P, i) cvtpk(P[i], P[i + 1])
#define PAF(k) __builtin_bit_cast(bf16x8, pw##k)
#define VFR(i) (bf16x8){vlo[i][0], vlo[i][1], vlo[i][2], vlo[i][3], vhi[i][0], vhi[i][1], vhi[i][2], vhi[i][3]}
#define VRD(i) do { vlo[i] = vtr(vp_ + (((i) >> 2) * 4096 + ((i) & 3) * 1024)); vhi[i] = vtr(vp_ + (((i) >> 2) * 4096 + ((i) & 3) * 1024 + 512)); } while (0)
#define KRD(G, d0) do { if (G) { kload2(kf, kp0 + sl_next, d0); SBAR(); } } while (0)
#define GAPA(MF, a0, a1, a2, a3, W0, W1, PW) do { MF; sacc += a0; sacc += a1; sacc += a2; sacc += a3; W0; W1; PIN(PW); PIN(sacc); SBAR(); } while (0)
#define GAPB(MF, X, i) do { MF; X[i] = EX(X[i]); X[i + 1] = EX(X[i + 1]); X[i + 2] = EX(X[i + 2]); X[i + 3] = EX(X[i + 3]); PIN(X); SBAR(); } while (0)
#define STEP(C0, C1, P0, P1, t, GK, GV, GL) do { SBAR(); \
    const lds_cptr vp_ = vp0 + sl_prev; const u32x2 mw_ = *(const LAS u32x2*)(mkp + (t) * 256); \
    VRD(0); SBAR(); float sacc = P0[0] + P0[1]; \
                    GAPA(C0 = MFMA32(kf[0], qr[0], zero16), P0[2], P0[3], P0[4], P0[5],     pw0[0] = PKW(P0, 0),  pw0[1] = PKW(P0, 2),  pw0); \
    VRD(4); SBAR(); GAPA(C1 = MFMA32(kf[1], qr[0], zero16), P0[6], P0[7], P0[8], P0[9],     pw0[2] = PKW(P0, 4),  pw0[3] = PKW(P0, 6),  pw0); \
    VRD(1); SBAR(); GAPA(C0 = MFMA32(kf[2], qr[1], C0),    P0[10], P0[11], P0[12], P0[13], pw1[0] = PKW(P0, 8),  pw1[1] = PKW(P0, 10), pw1); \
    VRD(5); SBAR(); GAPA(C1 = MFMA32(kf[3], qr[1], C1),    P0[14], P0[15], P1[0], P1[1],   pw1[2] = PKW(P0, 12), pw1[3] = PKW(P0, 14), pw1); \
    VRD(2); SBAR(); GAPA(C0 = MFMA32(kf[4], qr[2], C0),    P1[2], P1[3], P1[4], P1[5],     pw2[0] = PKW(P1, 0),  pw2[1] = PKW(P1, 2),  pw2); \
    VRD(6); SBAR(); GAPA(C1 = MFMA32(kf[5], qr[2], C1),    P1[6], P1[7], P1[8], P1[9],     pw2[2] = PKW(P1, 4),  pw2[3] = PKW(P1, 6),  pw2); \
    VRD(3); SBAR(); GAPA(C0 = MFMA32(kf[6], qr[3], C0),    P1[10], P1[11], P1[12], P1[13], pw3[0] = PKW(P1, 8),  pw3[1] = PKW(P1, 10), pw3); \
    VRD(7); SBAR(); GAPA(C1 = MFMA32(kf[7], qr[3], C1),    P1[14], P1[15], 0.f, 0.f,       pw3[2] = PKW(P1, 12), pw3[3] = PKW(P1, 14), pw3); \
    l_reg += sacc; \
    if (GK) DMA_K((t) + 3, sl_cur); if (GV) DMA_V((t) + 1, sl_next); \
    amask(C0, C1, mw_.x, mw_.y, hi); \
    { const float rm = __builtin_fmaf(rowmax(C0, C1), C2, -mhat); resc = false; \
      if (__builtin_expect(__any(rm > (float)THR), 0)) { const float dl = __builtin_fmaxf(rm, 0.f); mhat += dl; \
          const float f = __builtin_amdgcn_exp2f(-dl); l_reg *= f; if (hi == 0) wsf[r32] = f; resc = true; } } \
    const float nmh = -mhat; SBAR(); \
    GAPB(o[0] = MFMA32(PAF(0), VFR(0), o[0]), C0, 0);              GAPB(o[1] = MFMA32(PAF(0), VFR(4), o[1]), C0, 4); \
    KRD(GL, 0); GAPB(o[0] = MFMA32(PAF(1), VFR(1), o[0]), C0, 8);  KRD(GL, 1); GAPB(o[1] = MFMA32(PAF(1), VFR(5), o[1]), C0, 12); \
    KRD(GL, 2); GAPB(o[0] = MFMA32(PAF(2), VFR(2), o[0]), C1, 0);  KRD(GL, 3); GAPB(o[1] = MFMA32(PAF(2), VFR(6), o[1]), C1, 4); \
    GAPB(o[0] = MFMA32(PAF(3), VFR(3), o[0]), C1, 8);              GAPB(o[1] = MFMA32(PAF(3), VFR(7), o[1]), C1, 12); \
    } while (0)
    int t = 1;
    for (; t + 5 < NT; t += 2) {
        STEP(pB0, pB1, pA0, pA1, t, true, true, true);     WAIT_BAR(2); RESC(); ROT();
        STEP(pA0, pA1, pB0, pB1, t + 1, true, true, true); WAIT_BAR(2); RESC(); ROT();
    }
#define ENDW(tt) do { if ((tt) + 3 < NT) { WAIT_BAR(2); } else if ((tt) + 2 < NT) { WAIT_BAR(1); } else { WAIT_BAR(0); } } while (0)
    for (; t + 1 < NT; t += 2) {
        STEP(pB0, pB1, pA0, pA1, t, (t + 3 < NT), (t + 1 < NT), (t + 1 < NT));         ENDW(t);     RESC(); ROT();
        STEP(pA0, pA1, pB0, pB1, t + 1, (t + 4 < NT), (t + 2 < NT), (t + 2 < NT));     ENDW(t + 1); RESC(); ROT();
    }
    STEP(pB0, pB1, pA0, pA1, NT - 1, false, false, false); RESC();
    { float sacc = pB0[0] + pB0[1];
#pragma unroll
      for (int r = 2; r < 16; ++r) sacc += pB0[r];
#pragma unroll
      for (int r = 0; r < 16; ++r) sacc += pB1[r];
      l_reg += sacc;
      pw0 = (u32x4){PKW(pB0, 0), PKW(pB0, 2), PKW(pB0, 4), PKW(pB0, 6)}; pw1 = (u32x4){PKW(pB0, 8), PKW(pB0, 10), PKW(pB0, 12), PKW(pB0, 14)};
      pw2 = (u32x4){PKW(pB1, 0), PKW(pB1, 2), PKW(pB1, 4), PKW(pB1, 6)}; pw3 = (u32x4){PKW(pB1, 8), PKW(pB1, 10), PKW(pB1, 12), PKW(pB1, 14)};
      const lds_cptr vp_ = vp0 + sl_cur; _Pragma("unroll") for (int i = 0; i < 8; ++i) VRD(i);
      o[0] = MFMA32(PAF(0), VFR(0), o[0]); o[1] = MFMA32(PAF(0), VFR(4), o[1]); o[0] = MFMA32(PAF(1), VFR(1), o[0]); o[1] = MFMA32(PAF(1), VFR(5), o[1]);
      o[0] = MFMA32(PAF(2), VFR(2), o[0]); o[1] = MFMA32(PAF(2), VFR(6), o[1]); o[0] = MFMA32(PAF(3), VFR(3), o[0]); o[1] = MFMA32(PAF(3), VFR(7), o[1]); }
    { auto rr = __builtin_amdgcn_permlane32_swap(__float_as_uint(l_reg), __float_as_uint(l_reg), false, false); l_reg = __uint_as_float(rr[0]) + __uint_as_float(rr[1]); }
    if (hi == 0) wsf[32 + r32] = l_reg; asm volatile("s_waitcnt lgkmcnt(0)" ::: "memory");
    float rli[16];
#pragma unroll
    for (int r = 0; r < 16; ++r) rli[r] = __builtin_amdgcn_rcpf(wsf[32 + crow(r, hi)]);
    bf16_t* Ow = O + (rowbase + q0) * DMO + wid * 64; LAS bf16_t* stg = (LAS bf16_t*)(lds + LDS_OST) + wid * 2048;
#pragma unroll
    for (int r = 0; r < 16; ++r) { const int orow = crow(r, hi);
#pragma unroll
        for (int d0 = 0; d0 < 2; ++d0) stg[orow * 64 + d0 * 32 + r32] = (bf16_t)f2bf(o[d0][r] * rli[r]); }
    asm volatile("s_waitcnt lgkmcnt(0)" ::: "memory");
#pragma unroll
    for (int i = 0; i < 4; ++i) { const int row = i * 8 + (lane >> 3), ch = lane & 7; *(u32x4*)(Ow + (long)row * DMO + ch * 8) = *(const LAS u32x4*)(stg + row * 64 + ch * 8); }
    asm volatile("s_waitcnt lgkmcnt(0)\n\ts_barrier" ::: "memory");
#undef DMA_K
#undef DMA_V
#undef ROT
#undef EX
#undef RESC
#undef PKW
#undef PAF
#undef VFR
#undef VRD
#undef KRD
#undef ENDW
#undef GAPA
#undef GAPB
#undef STEP
}
__device__ __forceinline__ void attn_phase(LAS unsigned char* lds, const Bufs& B, const unsigned* MASK, int G, int vcu, bf16_t* Odst) {
    for (int p = vcu; p < NB * 32; p += G) {
        const int b = p >> 5, i = p & 31;
#pragma unroll 1
        for (int s2 = 0; s2 < 2; ++s2) attn_unit(b, s2 ? 63 - i : i, B.Q, B.K, B.V, MASK, Odst, (LAS char*)lds);
    }
}
#undef SBAR
#undef PIN
#undef MFMA32
#undef WAIT_BAR
#undef MX3
}

template <int WIN, int NIT> __device__ __forceinline__ void pool_items(LAS unsigned char* lds, const Bufs& B, int row0, int t0, int g, int q0) {
#pragma unroll 2
    for (int k = 0; k < NIT; ++k) {
        const int q = q0 + 64 * k, tl = q >> 4, c8 = 16 * g + (q & 15), t = t0 + tl;
        const int n = (t + 1 < WIN) ? t + 1 : WIN;
        f32x4 s0 = {0.f, 0.f, 0.f, 0.f}, s1 = {0.f, 0.f, 0.f, 0.f}, u0, u1;
        { const u32x4 w = *(const LAS u32x4*)(lds + (15 + tl) * 1024 + c8 * 16); unpack8(w, u0, u1); }
#pragma unroll
        for (int j = 0; j < WIN; ++j) { f32x4 a, b; const u32x4 w = *(const LAS u32x4*)(lds + (15 + tl - j) * 1024 + c8 * 16); unpack8(w, a, b); s0 += a; s1 += b; }
        const float inv = __builtin_amdgcn_rcpf((float)n);
        *(u32x4*)(B.YC + (size_t)(row0 + tl) * 1024 + 512 + 8 * c8) = pack8(s0 * inv - u0, s1 * inv - u1);
    }
}
__device__ __forceinline__ void pool_phase(LAS unsigned char* lds, const Bufs& B, int G, int vcu) {
    const int tid = threadIdx.x;
    constexpr int PT = 128, NLD = ((PT + 15) * 64 + 511) / 512;
    for (int tile = vcu; tile < T / PT; tile += G) {
        const int row0 = tile * PT, t0 = row0 & (S - 1);
        __syncthreads();
        {
            u32x4 v[NLD];
#pragma unroll
            for (int i = 0; i < NLD; ++i) { const int q = i * 512 + tid, lr = q >> 6, c8 = q & 63, tt = t0 - 15 + lr;
                v[i] = (u32x4){0u, 0u, 0u, 0u};
                if (tt >= 0 && lr < PT + 15) v[i] = *(const u32x4*)(B.U + (size_t)(row0 - 15 + lr) * PW + 8 * c8); }
#pragma unroll
            for (int i = 0; i < NLD; ++i) { const int q = i * 512 + tid, lr = q >> 6, c8 = q & 63;
                if (lr < PT + 15) *(LAS u32x4*)(lds + lr * 1024 + c8 * 16) = v[i]; }
        }
        __syncthreads();
        {
            const int wv = tid >> 6, ln = tid & 63;
            if (wv < 4) pool_items<16, PT / 16>(lds, B, row0, t0, 3, wv * (PT * 4) + ln);
            else if (wv < 6) pool_items<8, PT / 8>(lds, B, row0, t0, 2, (wv - 4) * (PT * 8) + ln);
            else if (wv == 6) pool_items<4, PT / 4>(lds, B, row0, t0, 1, ln);
            else pool_items<2, PT / 4>(lds, B, row0, t0, 0, ln);
        }
    }
    __syncthreads();
}
__device__ __forceinline__ void router_phase(LAS unsigned char* lds, const bf16_t* x2, const float* br, const Bufs& B, int G, int vcu) {
    const int tid = threadIdx.x, lane = tid & 63, wid = __builtin_amdgcn_readfirstlane(tid >> 6), tl = lane & 15, kg = lane >> 4;
    constexpr int WP = 2064, WLO = 32 * WP;
    LAS float* lgs = (LAS float*)lds + wid * (16 * 33);
    LAS int* cntl = (LAS int*)(lds + 2 * WLO);
    LAS int* basel = cntl + 32;
    LAS int* asg = basel + 32;
    LAS float* gl = (LAS float*)(asg + 512);
    LAS float* rl_ = gl + 512;
    for (int chunk = vcu; chunk < T / 128; chunk += G) {
        if (tid < 32) cntl[tid] = 0;
        {
            u32x4 wv[16];
#pragma unroll
            for (int i = 0; i < 16; ++i) { const int c = i * 512 + tid; wv[i] = ((const u32x4*)(c < 4096 ? B.WRH : B.WRL))[c & 4095]; }
#pragma unroll
            for (int i = 0; i < 16; ++i) { const int c = i * 512 + tid, cc = c & 4095; *(LAS u32x4*)(lds + (c < 4096 ? 0 : WLO) + (cc >> 7) * WP + (cc & 127) * 16) = wv[i]; }
        }
        const bf16_t* xrow = x2 + (size_t)(chunk * 128 + wid * 16 + tl) * D + 8 * kg;
        u32x4 xf[32];
#pragma unroll
        for (int ks = 0; ks < 32; ++ks) xf[ks] = *(const u32x4*)(xrow + 32 * ks);
        __syncthreads();
        f32x4 acc0 = {0.f, 0.f, 0.f, 0.f}, acc1 = {0.f, 0.f, 0.f, 0.f}; float ss = 0.f;
        const LAS unsigned char* wb = lds + tl * WP + 16 * kg;
#pragma unroll
        for (int ks = 0; ks < 32; ++ks) {
            const bf16x8 bh = __builtin_bit_cast(bf16x8, xf[ks]);
            const bf16x8 ah0 = *(const LAS bf16x8*)(wb + 64 * ks), ah1 = *(const LAS bf16x8*)(wb + 16 * WP + 64 * ks);
            const bf16x8 al0 = *(const LAS bf16x8*)(wb + WLO + 64 * ks), al1 = *(const LAS bf16x8*)(wb + WLO + 16 * WP + 64 * ks);
            acc0 = __builtin_amdgcn_mfma_f32_16x16x32_bf16(ah0, bh, acc0, 0, 0, 0); acc0 = __builtin_amdgcn_mfma_f32_16x16x32_bf16(al0, bh, acc0, 0, 0, 0);
            acc1 = __builtin_amdgcn_mfma_f32_16x16x32_bf16(ah1, bh, acc1, 0, 0, 0); acc1 = __builtin_amdgcn_mfma_f32_16x16x32_bf16(al1, bh, acc1, 0, 0, 0);
            f32x4 xa, xb; unpack8(xf[ks], xa, xb);
            ss += xa[0] * xa[0] + xa[1] * xa[1] + xa[2] * xa[2] + xa[3] * xa[3] + xb[0] * xb[0] + xb[1] * xb[1] + xb[2] * xb[2] + xb[3] * xb[3];
        }
        ss += __shfl_xor(ss, 16); ss += __shfl_xor(ss, 32);
        const float r = rsqrtf(ss * (1.0f / D) + EPS);
        if (kg == 0) rl_[wid * 16 + tl] = r;
        __syncthreads();
#pragma unroll
        for (int j = 0; j < 4; ++j) { lgs[tl * 33 + 4 * kg + j] = acc0[j] * r + br[4 * kg + j]; lgs[tl * 33 + 16 + 4 * kg + j] = acc1[j] * r + br[16 + 4 * kg + j]; }
        asm volatile("s_waitcnt lgkmcnt(0)" ::: "memory");
        if (lane < 16) {
            LAS float* lv = lgs + lane * 33;
            float v0 = 0.f, sum = 0.f; float ex[TOPK]; int ei[TOPK];
#pragma unroll
            for (int k = 0; k < TOPK; ++k) {
                int bi = 0; float bv = -3.0e38f;
                for (int e = 0; e < NE; ++e) { const float q = lv[e]; if (q > bv) { bv = q; bi = e; } }
                lv[bi] = -3.0e38f;
                if (k == 0) v0 = bv;
                ex[k] = __expf(bv - v0); sum += ex[k]; ei[k] = bi;
            }
            const float inv = 1.0f / sum;
#pragma unroll
            for (int k = 0; k < TOPK; ++k) {
                const int lr = __hip_atomic_fetch_add(&cntl[ei[k]], 1, __ATOMIC_RELAXED, __HIP_MEMORY_SCOPE_WORKGROUP);
                asg[(wid * 16 + lane) * 4 + k] = ei[k] | (lr << 8);
                gl[(wid * 16 + lane) * 4 + k] = ex[k] * inv;
            }
        }
        __syncthreads();
        if (tid < 32) basel[tid] = atomicAdd(&B.CNT[tid], cntl[tid]);
        __syncthreads();
        { const int v = asg[tid], e = v & 255, lr = v >> 8; const size_t pos = (size_t)e * T + basel[e] + lr;
          B.LIST[pos] = (chunk * 128 + (tid >> 2)) * 4 + (tid & 3); B.LISTG[pos] = gl[tid]; B.LISTR[pos] = rl_[tid >> 2]; }
        __syncthreads();
    }
}
__device__ __forceinline__ void combine_phase(float* out, const bf16_t* x2, const float* g, const Bufs& B, int G, int vcu) {
    const int lane = threadIdx.x & 63, gw = vcu * 8 + (threadIdx.x >> 6), NGW = G * 8;
    for (int row = gw; row < T; row += NGW) {
        f32x4* xr = (f32x4*)(out + (size_t)row * D) + lane;
        f32x4 v[4]; float s = 0.f;
#pragma unroll
        for (int j = 0; j < 4; ++j) {
            { const u32x2 xw = ((const u32x2*)(x2 + (size_t)row * D))[lane + 64 * j]; v[j].x = bf2f(xw.x & 0xffffu); v[j].y = bf2f(xw.x >> 16); v[j].z = bf2f(xw.y & 0xffffu); v[j].w = bf2f(xw.y >> 16); }
#pragma unroll
            for (int k = 0; k < 4; ++k) { const unsigned w = ((const unsigned*)((const fp8_t*)B.Y4 + ((size_t)row * 4 + k) * D))[lane + 64 * j];
                const f32x2 lo = __builtin_amdgcn_cvt_pk_f32_fp8((int)w, false), hi = __builtin_amdgcn_cvt_pk_f32_fp8((int)w, true);
                v[j].x += lo[0] * 0.125f; v[j].y += lo[1] * 0.125f; v[j].z += hi[0] * 0.125f; v[j].w += hi[1] * 0.125f; }
            s += v[j].x * v[j].x + v[j].y * v[j].y + v[j].z * v[j].z + v[j].w * v[j].w;
        }
        const float r = rsqrtf(wave_sum(s) * (1.0f / D) + EPS);
#pragma unroll
        for (int j = 0; j < 4; ++j) { const f32x4 gg = ((const f32x4*)g)[lane + 64 * j]; xr[64 * j] = v[j] * r * gg; }
    }
}

#define XB_TMO      128
#define XB_XCNT(j)  (256  + 64 * (j))
#define XB_XSUB(j)  (1280 + 64 * (j))
#define XB_XGEN(j)  (2304 + 64 * (j))
#define XB_TOP      3328
#define XB_TOPGEN   3392
#define XCD_BAR_WORDS 3456
#define XB_SPIN_CAP (1u << 18)
__device__ __forceinline__ unsigned xb_ld(unsigned* p)              { return __hip_atomic_load(p, __ATOMIC_RELAXED, __HIP_MEMORY_SCOPE_AGENT); }
__device__ __forceinline__ unsigned xb_add(unsigned* p, unsigned v) { return __hip_atomic_fetch_add(p, v, __ATOMIC_RELAXED, __HIP_MEMORY_SCOPE_AGENT); }
__device__ __forceinline__ unsigned xb_xcc_id() { return (unsigned)__builtin_amdgcn_s_getreg((3 << 11) | 20) & 0xFu; }
#define XB_SPIN(cond, bar) do { unsigned _sp = 0; while (cond) { __builtin_amdgcn_s_sleep(1); \
    if ((++_sp & 255u) == 0u) { if (xb_ld(&(bar)[XB_TMO])) break; if (_sp > XB_SPIN_CAP) { atomicAdd(&(bar)[XB_TMO], 1u); break; } } } } while (0)
struct XcdBarrier { unsigned* bar; unsigned x; volatile LAS unsigned* st; };
__device__ __forceinline__ XcdBarrier xcd_barrier_post(unsigned* bar, volatile LAS unsigned* st) {
    XcdBarrier b; b.bar = bar; b.x = xb_xcc_id(); b.st = st;
    if (threadIdx.x == 0) (void)xb_add(&bar[XB_XCNT(b.x)], 1u);
    return b;
}
__device__ __forceinline__ void xcd_barrier_complete(unsigned* bar, unsigned x, unsigned& nloc, unsigned& nx) {
    const unsigned G = gridDim.x * gridDim.y * gridDim.z;
    unsigned sum, cnt, mine, sp = 0u;
    for (;;) {
        sum = 0u; cnt = 0u; mine = 0u;
#pragma unroll
        for (unsigned j = 0; j < 16; ++j) { const unsigned c = xb_ld(&bar[XB_XCNT(j)]); sum += c; cnt += (c > 0u) ? 1u : 0u; mine = (j == x) ? c : mine; }
        if (sum == G) break;
        __builtin_amdgcn_s_sleep(1);
        if ((++sp & 255u) == 0u) { if (xb_ld(&bar[XB_TMO])) break; if (sp > XB_SPIN_CAP) { atomicAdd(&bar[XB_TMO], 1u); break; } }
    }
    nloc = mine > 0u ? mine : 1u; nx = cnt > 0u ? cnt : 1u;
}
__device__ __forceinline__ void xcd_barrier(const XcdBarrier& b) {
    asm volatile("s_waitcnt vmcnt(0)" ::: "memory");
    __syncthreads();
    if (threadIdx.x == 0) {
        unsigned* bar = b.bar;
        __builtin_amdgcn_s_waitcnt(0);
        unsigned nloc = b.st[0], nx = b.st[1];
        if (nloc == 0u) { xcd_barrier_complete(bar, b.x, nloc, nx); b.st[0] = nloc; b.st[1] = nx; }
        const unsigned old = xb_add(&bar[XB_XSUB(b.x)], 1u);
        const unsigned gen = old / nloc;
        if (old + 1u == (gen + 1u) * nloc) {
            __builtin_amdgcn_fence(__ATOMIC_RELEASE, "agent");
            asm volatile("s_waitcnt vmcnt(0)" ::: "memory");
            const unsigned og = xb_add(&bar[XB_TOP], 1u);
            const unsigned tg = og / nx;
            if (og + 1u == (tg + 1u) * nx) xb_add(&bar[XB_TOPGEN], 1u);
            else XB_SPIN(xb_ld(&bar[XB_TOPGEN]) == tg, bar);
            __builtin_amdgcn_fence(__ATOMIC_ACQUIRE, "agent");
            xb_add(&bar[XB_XGEN(b.x)], 1u);
            asm volatile("s_waitcnt vmcnt(0)" ::: "memory");
        } else {
            XB_SPIN(xb_ld(&bar[XB_XGEN(b.x)]) == gen, bar);
            __builtin_amdgcn_fence(__ATOMIC_ACQUIRE, "agent");
            asm volatile("s_waitcnt vmcnt(0)" ::: "memory");
        }
    }
    __syncthreads();
}

enum { PH_PRO = 0, PH_INPROJ = 1, PH_MASK = 2, PH_ATT = 3, PH_UP = 4, PH_OUT = 5, PH_ROUTER = 6, PH_GU = 7, PH_DOWN = 8, PH_COMB = 9, PH_N = 10 };

__global__ void __launch_bounds__(512, 2) mega(Args args) {
    extern __shared__ __attribute__((aligned(16))) unsigned char lds_raw[];
    LAS unsigned char* lds = (LAS unsigned char*)lds_raw;
    const int tid = threadIdx.x, lane = tid & 63, wave = __builtin_amdgcn_readfirstlane(tid >> 6);
    const int G = gridDim.x, bx = blockIdx.x;
    const int vcu = (G % 8 == 0) ? (bx % 8) * (G / 8) + bx / 8 : bx;
    unsigned char* ws = args.ws;
    Bufs B;
    B.HB = (bf16_t*)(ws + WS_HB); B.WIN = (bf16_t*)(ws + WS_WIN); B.WA = (bf16_t*)(ws + WS_WA); B.WC = (bf16_t*)(ws + WS_WC); B.WO = (bf16_t*)(ws + WS_WO);
    B.WGU = (bf16_t*)(ws + WS_WGU); B.WD = (bf16_t*)(ws + WS_WD); B.Q = (bf16_t*)(ws + WS_Q); B.K = (bf16_t*)(ws + WS_K); B.V = (bf16_t*)(ws + WS_V);
    B.IQ = (bf16_t*)(ws + WS_IQ); B.IK = (bf16_t*)(ws + WS_IK); B.U = (bf16_t*)(ws + WS_U); B.SGA = (bf16_t*)(ws + WS_SGA); B.SGP = (bf16_t*)(ws + WS_SGP);
    B.YC = (bf16_t*)(ws + WS_YC); B.YA = (bf16_t*)(ws + WS_YA); B.MX = (bf16_t*)(ws + WS_MX); B.ACT = (bf16_t*)(ws + WS_ACT); B.Y4 = (bf16_t*)(ws + WS_Y4);
    B.IW = (float*)(ws + WS_IW); B.GATE = (float*)(ws + WS_GATE); B.LIST = (int*)(ws + WS_LIST); B.CNT = (int*)(ws + WS_CTL);
    B.WRH = (bf16_t*)(ws + WS_WRH); B.WRL = (bf16_t*)(ws + WS_WRL); B.R2 = (float*)(ws + WS_R2);
    B.H8P = (fp8_t*)(ws + WS_MX); B.WIN8 = (fp8_t*)(ws + WS_WIN + 3 * MiB);
    B.H8 = (fp8_t*)(ws + WS_SGP);     B.WGU8 = (fp8_t*)(ws + WS_WGU); B.WD8 = (fp8_t*)(ws + WS_WD); B.ACT8 = (fp8_t*)(ws + WS_ACT); B.LISTR = (float*)(ws + WS_LISTR); B.LISTG = (float*)(ws + WS_LISTG);
    const float* x = args.in[0]; const float* norm_mix = args.in[1]; const float* w_in = args.in[2]; const float* w_pool = args.in[3]; const float* pool_scale = args.in[4];
    const float* w_attn_up = args.in[5]; const float* w_pool_up = args.in[6]; const float* w_out = args.in[7];
    const float* norm_ffn = args.in[8]; const float* w_router = args.in[9]; const float* b_router = args.in[10];
    const float* w_gate_up = args.in[11]; const float* b_gate_up = args.in[12]; const float* w_down = args.in[13]; const float* b_down = args.in[14]; const float* norm_final = args.in[15];
    const int lo = args.ph_lo, hi = args.ph_hi;
    if (tid < 4) ((LAS unsigned*)(lds + LDS_XB))[tid] = 0u;
    __syncthreads();
    const XcdBarrier xbar = xcd_barrier_post((unsigned*)(ws + WS_CTL) + CW_BAR, (volatile LAS unsigned*)(lds + LDS_XB));
#define IN(k) (lo <= (k) && (k) < hi)
#define SEAM(k) do { if (IN(k) && IN((k) + 1)) { xcd_barrier(xbar); } } while (0)

    if (IN(PH_PRO)) {
        LAS float* scr = (LAS float*)(lds + wave * 16384);
        const int gw = vcu * 8 + wave, NGW = G * 8;
        constexpr int I_IN = (D / 64) * (1536 / 32), I_IN8 = (D / 64) * (2048 / 32), I_A = (AW / 64) * (D / 32), I_O = (D / 64) * (D / 32), I_GU = (D / 64) * (F2 / 32), I_D = (D / 64) * (D / 32);
        constexpr int NITEMS = I_IN + I_A;
        LAS int* qctr = (LAS int*)(lds + 8 * 16384);
        if (tid == 0) *qctr = 0;
        __syncthreads();
        {
            f32x4 gm[4];
#pragma unroll
            for (int j = 0; j < 4; ++j) gm[j] = ((const f32x4*)norm_mix)[lane + 64 * j];
            const int NR = NGW;
            for (int m = gw; m < T; m += 4 * NR) {
                f32x4 v[4][4];
#pragma unroll
                for (int q = 0; q < 4; ++q)
#pragma unroll
                    for (int j = 0; j < 4; ++j) v[q][j] = ((const f32x4*)(x + (size_t)(m + q * NR) * D) + lane)[64 * j];
#pragma unroll
                for (int q = 0; q < 4; ++q) {
                    float s2 = 0.f;
#pragma unroll
                    for (int j = 0; j < 4; ++j) s2 += v[q][j].x * v[q][j].x + v[q][j].y * v[q][j].y + v[q][j].z * v[q][j].z + v[q][j].w * v[q][j].w;
                    const float r = rsqrtf(wave_sum(s2) * (1.0f / D) + EPS);
                    u32x2* o8 = (u32x2*)(B.HB + (size_t)(m + q * NR) * D) + lane;
                    unsigned* o4 = (unsigned*)(B.H8P + (size_t)(m + q * NR) * D) + lane;
#pragma unroll
                    for (int j = 0; j < 4; ++j) { u32x2 o; o.x = pk2(v[q][j].x * r, v[q][j].y * r); o.y = pk2(v[q][j].z * r, v[q][j].w * r); o8[64 * j] = o;
                        o4[64 * j] = pk4_fp8(v[q][j].x * r, v[q][j].y * r, v[q][j].z * r, v[q][j].w * r); }
                    if (lane == 0) B.R2[m + q * NR] = 1.0f / r;
                }
            }
        }
        const int NQ = 8 * ((NITEMS + NGW - 1) / NGW);
        for (;;) {
            int nq = 0;
            if (lane == 0) nq = __hip_atomic_fetch_add(qctr, 1, __ATOMIC_RELAXED, __HIP_MEMORY_SCOPE_WORKGROUP);
            nq = __builtin_amdgcn_readfirstlane(nq);
            if (nq >= NQ) break;
            const int it = vcu * 8 + (nq & 7) + (nq >> 3) * NGW;
            if (it >= NITEMS) continue;
            int r = it;
            if (r < I_IN) { transpose_item<1>(w_in, D, INC, B.WIN, scr, r, 1536 / 32, lane, 0, norm_mix); continue; } r -= I_IN;
            { transpose_item<0>(w_attn_up, AW, D, B.WA, scr, r, D / 32, lane, AW + PW); }
        }
        for (int it = gw; it < 4 * 64 * 8; it += NGW) {
            const int g = it >> 9, nt_ = (it >> 3) & 63, ct = it & 7, i16 = lane & 15, kq = lane >> 4;
            const f32x4* wp = (const f32x4*)(w_pool + (size_t)(g * 128 + ct * 16 + i16) * 128 + kq * 32);
            const f32x4* ps = (const f32x4*)(pool_scale + g * 128 + kq * 32);
            const float* wu = w_pool_up + (size_t)(g * 128 + kq * 32) * D + nt_ * 16 + i16;
            f32x4 a4[8], p4[8]; float bv[32];
#pragma unroll
            for (int q = 0; q < 8; ++q) { a4[q] = wp[q]; p4[q] = ps[q]; }
#pragma unroll
            for (int q = 0; q < 32; ++q) bv[q] = wu[(size_t)q * D];
            f32x4 acc = {0.f, 0.f, 0.f, 0.f};
#pragma unroll
            for (int q = 0; q < 32; ++q) acc = __builtin_amdgcn_mfma_f32_16x16x4f32(a4[q >> 2][q & 3] * p4[q >> 2][q & 3], bv[q], acc, 0, 0, 0);
            u32x2 o; o.x = pk2(acc[0], acc[1]); o.y = pk2(acc[2], acc[3]);
            *(u32x2*)(B.WA + (size_t)(nt_ * 16 + i16) * (AW + PW) + AW + g * 128 + ct * 16 + 4 * kq) = o;
        }
        for (int idx = vcu * 512 + tid; idx < NE * D; idx += G * 512) { const int e = idx >> 10, k = idx & (D - 1); const float w = w_router[(size_t)k * NE + e] * norm_ffn[k]; const unsigned hh = f2bf(w); B.WRH[idx] = (bf16_t)hh; B.WRL[idx] = (bf16_t)f2bf(w - bf2f(hh)); }
        __syncthreads();
        for (int tile = vcu; tile < NE * 64 + NE * 32; tile += G) {
            if (tile < NE * 64) { const int e = tile >> 6, kt = (tile >> 3) & 7, nt = tile & 7;
                transpose_tile_f8<2>(w_gate_up + (size_t)e * D * F2, D, F2, B.WGU8 + (size_t)e * F2 * D, lds, kt, nt); }
            else { const int tl = tile - NE * 64, e = tl >> 5, kt = (tl >> 2) & 7, nt = tl & 3;
                transpose_tile_f8<0>(w_down + (size_t)e * D * D, D, D, B.WD8 + (size_t)e * D * D, lds, kt, nt); }
        }
        for (int tl = G - 1 - vcu; tl < 64 + 32; tl += G) {
            if (tl < 64) { const int kt = tl >> 3, nt = tl & 7;
                transpose_tile_f8<0>(w_in, D, INC, B.WIN8, lds, kt, nt, nt < 4 ? C_GA + 256 * nt : C_GP + 256 * (nt - 4), norm_mix); }
            else { const int t2 = tl - 64, kt = t2 >> 2, nt = t2 & 3;
                transpose_tile_f8<0>(w_out, D, D, (fp8_t*)B.WO, lds, kt, nt); } }
    }
    SEAM(PH_PRO);
    if (IN(PH_INPROJ)) {
        { pg::StaticOrder So; So.init(T, 1536, G, bx, B.HB, D, B.WIN, D); EpiInProj E{B, 0}; pg::gemm_phase<EpiInProj, pg::StaticOrder, false>(lds, D, D, D, So, E); }
        asm volatile("s_waitcnt vmcnt(0)" ::: "memory"); __syncthreads();
        { pg::StaticOrder So; So.init(T, 2048, G, bx, B.H8P, D / 2, B.WIN8, D / 2); EpiInProj E{B, 6}; pg::gemm_phase<EpiInProj, pg::StaticOrder, false, true>(lds, D / 2, D / 2, D / 2, So, E); }
    }
    SEAM(PH_INPROJ);
    unsigned* MASK = (unsigned*)(ws + WS_MASK);
    if (IN(PH_MASK)) {
        pool_phase(lds, B, G, vcu);
        dsa_mask_phase(lds, B, MASK, G, vcu);
    }
    SEAM(PH_MASK);
    if (IN(PH_ATT)) att::attn_phase(lds, B, MASK, G, vcu, B.YC);
    SEAM(PH_ATT);
    if (IN(PH_UP)) {
        pg::StaticOrder So; So.init(T, D, G, bx, B.YC, D, B.WA, AW + PW); EpiUpFused E{B}; pg::gemm_phase<EpiUpFused, pg::StaticOrder, false>(lds, AW + PW, D, AW + PW, So, E);
    }
    SEAM(PH_UP);
    if (IN(PH_OUT)) {
        pg::StaticOrder So; So.init(T, D, G, bx, B.MX, D / 2, B.WO, D / 2);
        EpiOut E{B.HB, B.YA, B.H8, norm_ffn, B.R2};
        pg::gemm_phase<EpiOut, pg::StaticOrder, false, true>(lds, D / 2, D / 2, D / 2, So, E);
    }
    SEAM(PH_OUT);
    if (IN(PH_ROUTER)) router_phase(lds, B.YA, b_router, B, G, vcu);
    SEAM(PH_ROUTER);
    if (IN(PH_GU)) {
        LAS int* tab = (LAS int*)(lds + LDS_TAB);
        moe_tables(tab, B.CNT, 8);
        MoeOrder Mo; Mo.tab = tab; Mo.NT = 8; Mo.G = G; Mo.c = vcu; Mo.total = tab[NE]; Mo.Abase = (const char*)B.H8; Mo.Bbase = (const char*)B.WGU8; Mo.bexp = (size_t)F2 * D; Mo.list = B.LIST; Mo.dense_a = false;
        Mo.total = __builtin_amdgcn_readfirstlane(Mo.total);
        EpiGateUp E{B.ACT8, b_gate_up, B.LISTR};
        pg::gemm_phase<EpiGateUp, MoeOrder, true, true>(lds, D / 2, D / 2, D / 2, Mo, E);
        __syncthreads();
    }
    SEAM(PH_GU);
    if (IN(PH_DOWN)) {
        LAS int* tab = (LAS int*)(lds + LDS_TAB);
        moe_tables(tab, B.CNT, 4);
        MoeOrder Mo; Mo.tab = tab; Mo.NT = 4; Mo.G = G; Mo.c = vcu; Mo.total = tab[NE]; Mo.Abase = (const char*)B.ACT8; Mo.Bbase = (const char*)B.WD8; Mo.bexp = (size_t)D * D; Mo.list = B.LIST; Mo.dense_a = true;
        Mo.total = __builtin_amdgcn_readfirstlane(Mo.total);
        EpiDown E{(fp8_t*)B.Y4, b_down, B.LISTG, B.LIST};
        pg::gemm_phase<EpiDown, MoeOrder, false, true>(lds, D / 2, D / 2, D / 2, Mo, E);
    }
    SEAM(PH_DOWN);
    if (IN(PH_COMB)) combine_phase(args.out, B.YA, norm_final, B, G, vcu);
#undef IN
#undef SEAM
}

extern "C" void kernel_launch(void* const* d_in, const int* in_sizes, int n_in, void* d_out, int out_size, void* d_ws, size_t ws_size, hipStream_t stream) {
    static int grid = 0;
    if (grid == 0) {
        if (ws_size < WS_END) { fprintf(stderr, "kernel_launch: workspace too small (%zu < %zu)\n", ws_size, (size_t)WS_END); grid = -1; return; }
        int dev = 0, cus = 0, per_cu = 0;
        (void)hipGetDevice(&dev); (void)hipDeviceGetAttribute(&cus, hipDeviceAttributeMultiprocessorCount, dev);
        (void)hipFuncSetAttribute((const void*)mega, hipFuncAttributeMaxDynamicSharedMemorySize, LDS_BYTES);
        (void)hipOccupancyMaxActiveBlocksPerMultiprocessor(&per_cu, (const void*)mega, 512, LDS_BYTES);
        if (per_cu < 1) { fprintf(stderr, "kernel_launch: occupancy query says %d blocks/CU\n", per_cu); grid = -1; return; }
        grid = cus;
    }
    if (grid < 0) return;
    unsigned char* ws = (unsigned char*)d_ws;
    (void)hipMemsetAsync(ws + WS_CTL, 0, 32768, stream);
    Args a{};
    for (int i = 0; i < 16; ++i) a.in[i] = (const float*)d_in[i];
    a.out = (float*)d_out; a.ws = ws; a.ph_lo = 0; a.ph_hi = PH_N;
    void* kargs[] = {&a};
    hipError_t e = hipLaunchCooperativeKernel((const void*)mega, dim3(grid), dim3(512), kargs, LDS_BYTES, stream);
    if (e != hipSuccess) fprintf(stderr, "kernel_launch: cooperative launch failed: %s (grid %d)\n", hipGetErrorString(e), grid);
}
```
